# Optimizing an MI355X kernel written in HIP

```python
import math
import jax
import jax.numpy as jnp
from jax import lax
import numpy as np

D_MODEL = 4096
BATCH = 1
SEQ = 8192
DEPTH = 1

HEAD_DIM = 128
ATTN_PATTERNS = ((128, 1), (512, 4), (2048, 16))
N_ATTN_GROUPS = 3
ATTN_HEADS_PER_GROUP = 8
ATTN_WIDTH = N_ATTN_GROUPS * ATTN_HEADS_PER_GROUP * HEAD_DIM
ATTN_OUT_WIDTH = ATTN_HEADS_PER_GROUP * HEAD_DIM
DN_HEADS = 16
DN_WIDTH = DN_HEADS * HEAD_DIM
CONV_K = 4
DN_CHUNK = 64
D_FF = 4 * D_MODEL
PLE_DIM = 256
EPS = 1e-6
IN_SPLITS = (ATTN_WIDTH, ATTN_WIDTH, ATTN_WIDTH, 3 * DN_WIDTH, DN_WIDTH, DN_HEADS, DN_HEADS, D_MODEL, D_MODEL)
IN_WIDTH = sum(IN_SPLITS)

kernel_name = "hybrid_dilated_attn_gated_deltanet_block"


def _split_points(sizes):
    pts, acc = [], 0
    for n in sizes[:-1]:
        acc += n
        pts.append(acc)
    return pts


def rmsnorm(x, g):
    xf = x.astype(jnp.float32)
    y = xf * lax.rsqrt(jnp.mean(xf * xf, axis=-1, keepdims=True) + EPS)
    return (y * g.astype(jnp.float32)).astype(x.dtype)


def l2norm(t):
    return t * lax.rsqrt(jnp.sum(t * t, axis=-1, keepdims=True) + EPS)


def dilated_window_attention(q, k, v, window, dilation):
    b, s, g, hd = q.shape
    span = window // dilation
    L = s // dilation
    nb = -(-L // span)
    Lp = nb * span

    def to_sub(t):
        t = t.reshape(b, L, dilation, g, hd).transpose(0, 2, 1, 3, 4)
        t = jnp.pad(t, ((0, 0), (0, 0), (0, Lp - L), (0, 0), (0, 0)))
        return t.reshape(b, dilation, nb, span, g, hd)

    def with_prev(t):
        prev = jnp.pad(t, ((0, 0), (0, 0), (1, 0), (0, 0), (0, 0), (0, 0)))[:, :, :-1]
        return jnp.concatenate([prev, t], axis=3)

    qs = to_sub(q)
    kk = with_prev(to_sub(k))
    vv = with_prev(to_sub(v))
    scores = jnp.einsum('brnqhd,brnkhd->brnhqk', qs, kk).astype(jnp.float32) * (hd ** -0.5)
    qi = jnp.arange(span)[:, None]
    kj = jnp.arange(2 * span)[None, :]
    dist = qi + span - kj
    band = (dist >= 0) & (dist <= span)
    valid = band[None] & ((jnp.arange(nb)[:, None, None] > 0) | (kj[None] >= span))
    scores = jnp.where(valid[None, None, :, None], scores, -jnp.inf)
    m = jnp.max(scores, axis=-1, keepdims=True)
    e = jnp.exp(scores - m)
    l = jnp.sum(e, axis=-1, keepdims=True)
    o = jnp.einsum('brnhqk,brnkhd->brnqhd', (e / l).astype(v.dtype), vv)
    lse = (m + jnp.log(l))[..., 0]
    o = o.reshape(b, dilation, Lp, g, hd)[:, :, :L].transpose(0, 2, 1, 3, 4).reshape(b, s, g, hd)
    lse = lse.transpose(0, 1, 2, 4, 3).reshape(b, dilation, Lp, g)[:, :, :L]
    lse = lse.transpose(0, 2, 1, 3).reshape(b, s, g)
    return o, lse


def causal_conv_silu(x, w):
    kw = w.shape[0]
    s = x.shape[1]
    xp = jnp.pad(x, ((0, 0), (kw - 1, 0), (0, 0)))
    y = sum(xp[:, j:j + s] * w[j] for j in range(kw))
    return jax.nn.silu(y)


def chunked_gated_delta_rule(q, k, v, g, beta):
    b, s, h, dk = q.shape
    dv = v.shape[-1]
    c = DN_CHUNK
    nc = s // c
    q = q * dk ** -0.5

    def chunks(t):
        t = jnp.moveaxis(t, 2, 1)
        return t.reshape((b, h, nc, c) + t.shape[3:])

    qc, kc, vc = chunks(q), chunks(k), chunks(v)
    gc = jnp.cumsum(chunks(g), axis=-1)
    bc = chunks(beta)
    lower = jnp.tril(jnp.ones((c, c), dtype=bool))
    strict = jnp.tril(jnp.ones((c, c), dtype=bool), -1)
    decay = jnp.exp(jnp.where(lower, gc[..., :, None] - gc[..., None, :], -jnp.inf))
    kb = kc * bc[..., None]
    a = jnp.where(strict, jnp.einsum('bhnid,bhnjd->bhnij', kb, kc) * decay, 0.0)
    eye = jnp.eye(c, dtype=a.dtype)
    t_inv = lax.linalg.triangular_solve(eye + a, jnp.broadcast_to(eye, a.shape),
                                        left_side=True, lower=True, unit_diagonal=True)
    u = jnp.einsum('bhnij,bhnjd->bhnid', t_inv, vc * bc[..., None])
    w = jnp.einsum('bhnij,bhnjd->bhnid', t_inv, kb * jnp.exp(gc)[..., None])
    intra = jnp.where(lower, jnp.einsum('bhnid,bhnjd->bhnij', qc, kc) * decay, 0.0)
    g_last = gc[..., -1]
    k_dec = kc * jnp.exp(g_last[..., None] - gc)[..., None]
    q_dec = qc * jnp.exp(gc)[..., None]

    def step(state, xs):
        q_i, k_i, u_i, w_i, a_i, gl_i = xs
        v_new = u_i - jnp.einsum('bhcd,bhde->bhce', w_i, state)
        o_i = jnp.einsum('bhcd,bhde->bhce', q_i, state) + jnp.einsum('bhij,bhje->bhie', a_i, v_new)
        state = state * jnp.exp(gl_i)[..., None, None] + jnp.einsum('bhcd,bhce->bhde', k_i, v_new)
        return state, o_i

    xs = tuple(jnp.moveaxis(t, 2, 0) for t in (q_dec, k_dec, u, w, intra, g_last))
    state0 = jnp.zeros((b, h, dk, dv), jnp.float32)
    _, o = lax.scan(step, state0, xs)
    o = jnp.moveaxis(o, 0, 2).reshape(b, h, s, dv)
    return jnp.moveaxis(o, 1, 2)


def setup_inputs(seed: int = 0) -> dict:
    key = jax.random.key(seed)
    ks = jax.random.split(key, 20)
    f32 = jnp.float32

    def nrm(kk, shape, fan_in):
        return jax.random.normal(kk, shape, f32) * fan_in ** -0.5

    def gain(kk, shape):
        return 1.0 + 0.02 * jax.random.normal(kk, shape, f32)

    dt = jnp.exp(jax.random.uniform(ks[5], (DEPTH, DN_HEADS), f32, math.log(1e-3), math.log(1e-1)))
    return {
        "x": jax.random.normal(ks[0], (BATCH, SEQ, D_MODEL), f32),
        "p": jax.random.normal(ks[1], (DEPTH, BATCH, SEQ, PLE_DIM), f32),
        "w_in": nrm(ks[2], (DEPTH, D_MODEL, IN_WIDTH), D_MODEL),
        "conv_w": nrm(ks[3], (DEPTH, CONV_K, 3 * DN_WIDTH), CONV_K),
        "dn_a_log": jnp.log(jax.random.uniform(ks[4], (DEPTH, DN_HEADS), f32, 1.0, 16.0)),
        "dn_dt_bias": dt + jnp.log(-jnp.expm1(-dt)),
        "dn_norm": gain(ks[6], (DEPTH, HEAD_DIM)),
        "w_attn_up": nrm(ks[7], (DEPTH, ATTN_OUT_WIDTH, D_MODEL), ATTN_OUT_WIDTH),
        "w_dn_up": nrm(ks[8], (DEPTH, DN_WIDTH, D_MODEL), DN_WIDTH),
        "w_out": nrm(ks[9], (DEPTH, D_MODEL, D_MODEL), D_MODEL),
        "w_mlp_up": nrm(ks[10], (DEPTH, D_MODEL, D_FF), D_MODEL),
        "w_mlp_down": nrm(ks[11], (DEPTH, D_FF, D_MODEL), D_FF),
        "w_ple_gate": nrm(ks[12], (DEPTH, D_MODEL, D_MODEL), D_MODEL),
        "w_ple_proj": nrm(ks[13], (DEPTH, PLE_DIM, D_MODEL), PLE_DIM),
        "norm_mix": gain(ks[14], (DEPTH, D_MODEL)),
        "norm_mlp": gain(ks[15], (DEPTH, D_MODEL)),
        "norm_ple": gain(ks[16], (DEPTH, D_MODEL)),
        "ple_post_norm": gain(ks[17], (DEPTH, D_MODEL)),
        "final_norm": gain(ks[18], (D_MODEL,)),
    }


def reference(x, p, w_in, conv_w, dn_a_log, dn_dt_bias, dn_norm, w_attn_up, w_dn_up, w_out,
              w_mlp_up, w_mlp_down, w_ple_gate, w_ple_proj, norm_mix, norm_mlp, norm_ple,
              ple_post_norm, final_norm):
    b, s, _ = x.shape
    f32 = jnp.float32
    for i in range(DEPTH):
        h = rmsnorm(x, norm_mix[i])
        q_a, k_a, v_a, qkv_b, z_b, beta_raw, alpha_raw, gate_a, gate_b = jnp.split(
            h @ w_in[i], _split_points(IN_SPLITS), axis=-1)

        def grp(t):
            return t.reshape(b, s, N_ATTN_GROUPS, ATTN_HEADS_PER_GROUP, HEAD_DIM)
        q_a, k_a, v_a = grp(q_a), grp(k_a), grp(v_a)
        outs, lses = [], []
        for gi, (window, dilation) in enumerate(ATTN_PATTERNS):
            o_g, lse_g = dilated_window_attention(q_a[:, :, gi], k_a[:, :, gi], v_a[:, :, gi], window, dilation)
            outs.append(o_g)
            lses.append(lse_g)
        wts = jax.nn.softmax(jnp.stack(lses, axis=0), axis=0)
        o_a = jnp.sum(wts[..., None] * jnp.stack(outs, axis=0).astype(f32), axis=0)
        o_a = o_a.reshape(b, s, ATTN_OUT_WIDTH).astype(x.dtype)

        qkv_b = causal_conv_silu(qkv_b, conv_w[i]).astype(f32)
        q_b, k_b, v_b = [t.reshape(b, s, DN_HEADS, HEAD_DIM) for t in jnp.split(qkv_b, 3, axis=-1)]
        q_b, k_b = l2norm(q_b), l2norm(k_b)
        beta = jax.nn.sigmoid(beta_raw.astype(f32))
        g = -jnp.exp(dn_a_log[i].astype(f32)) * jax.nn.softplus(alpha_raw.astype(f32) + dn_dt_bias[i].astype(f32))
        o_b = chunked_gated_delta_rule(q_b, k_b, v_b, g, beta)
        o_b = rmsnorm(o_b, dn_norm[i]) * jax.nn.silu(z_b.astype(f32).reshape(b, s, DN_HEADS, HEAD_DIM))
        o_b = o_b.reshape(b, s, DN_WIDTH).astype(x.dtype)

        merged = jax.nn.sigmoid(gate_a) * (o_a @ w_attn_up[i]) + jax.nn.sigmoid(gate_b) * (o_b @ w_dn_up[i])
        x = x + merged @ w_out[i]

        h = rmsnorm(x, norm_mlp[i])
        x = x + jnp.square(jax.nn.relu(h @ w_mlp_up[i])) @ w_mlp_down[i]

        gate = jax.nn.sigmoid(rmsnorm(x, norm_ple[i]) @ w_ple_gate[i])
        x = x + gate * rmsnorm(p[i] @ w_ple_proj[i], ple_post_norm[i])
    return rmsnorm(x, final_norm)
```

```cpp
#include <hip/hip_runtime.h>
#include <cstdio>
#include <cstdint>
__device__ __forceinline__ int otid() { int t = threadIdx.x; asm volatile("" : "+v"(t)); return t; }
__host__ __device__ __forceinline__ size_t kt_off(size_t row, int k, int Ktot) { return ((((row >> 7) * (size_t)(Ktot >> 6) + (size_t)(k >> 6)) << 7) + (row & 127)) * 64 + (size_t)(k & 63); }
namespace pg8 {
#define PG8_LAS __attribute__((address_space(3)))
typedef unsigned short bf16_t;
typedef short bf16x8 __attribute__((ext_vector_type(8)));
typedef float f32x4 __attribute__((ext_vector_type(4)));
typedef unsigned u32x4 __attribute__((ext_vector_type(4)));
constexpr int BM = 256, BK = 64, HALF = 128, HTB = HALF * BK * 2  , STAGE_BYTES = 8 * HTB, NXCD = 8, WGM = 8;

__host__ __device__ __forceinline__ int lds_byte(int r, int c) { const int st = (r >> 4) * 2 + (c >> 5), rr = r & 15, cc = c & 31, ob = rr * 64 + cc * 2; return st * 1024 + (ob ^ (((ob >> 9) & 1) << 5)); }
__host__ __device__ __forceinline__ void stage_rc(int b, int& R, int& C) { const int st = b / 1024, sb = b % 1024, swz = sb ^ (((sb >> 9) & 1) << 5); R = (st >> 1) * 16 + swz / 64; C = (st & 1) * 32 + (swz % 64) / 2; }
__host__ __device__ __forceinline__ int perm32(int rho) { const int n = rho >> 4, i = rho & 15; return 8 * (i >> 2) + 4 * n + (i & 3); }

struct Unit { int pm, pn, seg; };
struct Gemm { const bf16_t* A; const bf16_t* Bt; int M, N, K, ld; };

struct StaticOrder {
    int nM, nN, nwg, G, c;
    __host__ __device__ void init(int M, int N, int G_, int c_) { nM = M / BM; nN = N / BM; nwg = nM * nN; G = G_; c = c_; }
    __host__ __device__ bool next(int i, Unit& u) const {
        const long L = (long)i * G + c; if (L >= nwg) return false;
        int wgid = (int)L; { const int q = nwg / NXCD, r = nwg % NXCD, xcd = wgid % NXCD, off = wgid / NXCD; wgid = (xcd < r ? xcd * (q + 1) : r * (q + 1) + (xcd - r) * q) + off; }
        const int nig = WGM * nN, gid = wgid / nig, fm = gid * WGM, gsz = (nM - fm) < WGM ? (nM - fm) : WGM;
        u.pm = fm + ((wgid % nig) % gsz); u.pn = (wgid % nig) / gsz; return true;
    }
    __device__ __forceinline__ void a_ready(const Unit&) const {}
    __device__ __forceinline__ void done(const Unit&) const {}
};
typedef float f32x2_t __attribute__((ext_vector_type(2))); typedef __bf16 bf16x2_t __attribute__((ext_vector_type(2)));
__device__ __forceinline__ unsigned cvt_pk_bf16(float lo, float hi) { const f32x2_t v = {lo, hi}; const bf16x2_t b = __builtin_convertvector(v, bf16x2_t); return __builtin_bit_cast(unsigned, b); }

typedef unsigned u32x2 __attribute__((ext_vector_type(2)));
__device__ __forceinline__ float sigm(float x) { return __builtin_amdgcn_rcpf(1.0f + __builtin_amdgcn_exp2f(-1.4426950408889634f * x)); }
__device__ __forceinline__ f32x4 sigm4(f32x4 x) { return (f32x4){sigm(x[0]), sigm(x[1]), sigm(x[2]), sigm(x[3])}; }
__device__ __forceinline__ void unpack8(u32x4 w, f32x4& a, f32x4& b) {
    a = (f32x4){__uint_as_float(w.x << 16), __uint_as_float(w.x & 0xffff0000u), __uint_as_float(w.y << 16), __uint_as_float(w.y & 0xffff0000u)};
    b = (f32x4){__uint_as_float(w.z << 16), __uint_as_float(w.z & 0xffff0000u), __uint_as_float(w.w << 16), __uint_as_float(w.w & 0xffff0000u)};
}
__device__ __forceinline__ u32x4 pack8(f32x4 v0, f32x4 v1) { u32x4 w; w.x = cvt_pk_bf16(v0[0], v0[1]); w.y = cvt_pk_bf16(v0[2], v0[3]); w.z = cvt_pk_bf16(v1[0], v1[1]); w.w = cvt_pk_bf16(v1[2], v1[3]); return w; }
#define EPI_ROWS(...) \
    _Pragma("unroll") for (int ai = 0; ai < 2; ++ai) _Pragma("unroll") for (int m = 0; m < 4; ++m) { const size_t row = (size_t)(row0 + ai * HALF + m * 16); \
        _Pragma("unroll") for (int bj = 0; bj < 2; ++bj) { const int col = col0 + bj * HALF; const f32x4 v0 = acc[ai][bj][m][0], v1 = acc[ai][bj][m][1]; __VA_ARGS__ } \
        asm volatile("" ::: "memory"); }
#define EPI_HEAD const int row0 = u.pm * BM + wr * 64 + fr, col0 = u.pn * BM + wc * 32 + 8 * fq;

constexpr int EP_ATT_TILE0 = 65, EP_LSEQ = 13;
struct EpiProj {
    static constexpr bool PERM = true, AFTER_DRAIN = false; static constexpr int MIDK = 0;
    bf16_t* O; int ldc; float* BA; int ba_tile; bf16_t* AQ; int tile0;
    __device__ __forceinline__ void operator()(const f32x4 (&acc)[2][2][4][2], const Unit& u, int wr, int wc, int fr, int fq) const {
        EPI_HEAD
        if (u.pn == ba_tile) {
            if (wc == 0) {
#pragma unroll
                for (int ai = 0; ai < 2; ++ai)
#pragma unroll
                    for (int m = 0; m < 4; ++m) { float* rp = BA + (size_t)(row0 + ai * HALF + m * 16) * 32 + 8 * fq; *(f32x4*)rp = acc[ai][0][m][0]; *(f32x4*)(rp + 4) = acc[ai][0][m][1]; }
            }
            return;
        }
        const int gt = tile0 + u.pn;
        if (gt >= EP_ATT_TILE0) {
            const int a = gt - EP_ATT_TILE0, which = a / 12, g = (a % 12) >> 2, hb = (a & 3) << 1, ld = 2 * g;
            bf16_t* base = AQ + ((size_t)((which * 3 + g) * 8 + hb) << (EP_LSEQ + 7)) + wc * 32 + 8 * fq;
#pragma unroll
            for (int ai = 0; ai < 2; ++ai)
#pragma unroll
                for (int m = 0; m < 4; ++m) { const int t = row0 + ai * HALF + m * 16; const int pos = ((t & ((1 << ld) - 1)) << (EP_LSEQ - ld)) + (t >> ld);
#pragma unroll
                    for (int bj = 0; bj < 2; ++bj) __builtin_nontemporal_store(pack8(acc[ai][bj][m][0], acc[ai][bj][m][1]), (u32x4*)(base + ((size_t)bj << (EP_LSEQ + 7)) + (size_t)pos * 128));
                    asm volatile("" ::: "memory"); }
            return;
        }
        EPI_ROWS( __builtin_nontemporal_store(pack8(v0, v1), (u32x4*)(O + row * ldc + col)); )
    }
};
struct EpiGate1 {
    static constexpr bool PERM = true, AFTER_DRAIN = false; static constexpr int MIDK = 0;
    const bf16_t* G; int ldg; float* T; int ldt;
    __device__ __forceinline__ void operator()(const f32x4 (&acc)[2][2][4][2], const Unit& u, int wr, int wc, int fr, int fq) const {
        EPI_HEAD
        EPI_ROWS( f32x4 g0, g1; unpack8(*(const u32x4*)(G + row * ldg + col), g0, g1); float* tp = T + row * ldt + col; *(f32x4*)tp = sigm4(g0) * v0; *(f32x4*)(tp + 4) = sigm4(g1) * v1; )
    }
};
struct EpiGate2 {
    static constexpr bool PERM = true, AFTER_DRAIN = false; static constexpr int MIDK = 0;
    const bf16_t* G; int ldg; const float* T; int ldt; bf16_t* O; int ldo;
    __device__ __forceinline__ void operator()(const f32x4 (&acc)[2][2][4][2], const Unit& u, int wr, int wc, int fr, int fq) const {
        EPI_HEAD
        EPI_ROWS( f32x4 g0, g1; unpack8(*(const u32x4*)(G + row * ldg + col), g0, g1); const float* tp = T + row * ldt + col;
                  const f32x4 t0 = *(const f32x4*)tp, t1 = *(const f32x4*)(tp + 4); *(u32x4*)(O + row * ldo + col) = pack8(t0 + sigm4(g0) * v0, t1 + sigm4(g1) * v1); )
    }
};
struct EpiResid {
    static constexpr bool PERM = true, AFTER_DRAIN = false; static constexpr int MIDK = 0;
    const float* X; float* Y; int ldx;
    __device__ __forceinline__ void operator()(const f32x4 (&acc)[2][2][4][2], const Unit& u, int wr, int wc, int fr, int fq) const {
        EPI_HEAD
        EPI_ROWS( const float* xp = X + row * ldx + col; float* yp = Y + row * ldx + col; const f32x4 x0 = *(const f32x4*)xp, x1 = *(const f32x4*)(xp + 4); *(f32x4*)yp = x0 + v0; *(f32x4*)(yp + 4) = x1 + v1; )
    }
};
struct EpiRelu2 {
    static constexpr bool PERM = true, AFTER_DRAIN = false; static constexpr int MIDK = 0;
    bf16_t* O; int ldo;
    __device__ __forceinline__ void operator()(const f32x4 (&acc)[2][2][4][2], const Unit& u, int wr, int wc, int fr, int fq) const {
        EPI_HEAD
        EPI_ROWS( const f32x4 z = {0.f, 0.f, 0.f, 0.f}; const f32x4 r0 = __builtin_elementwise_max(v0, z), r1 = __builtin_elementwise_max(v1, z); *(u32x4*)(O + row * ldo + col) = pack8(r0 * r0, r1 * r1); )
    }
};
struct EpiF32 {
    static constexpr bool PERM = true, AFTER_DRAIN = false; static constexpr int MIDK = 0;
    float* O; int ldo;
    __device__ __forceinline__ void operator()(const f32x4 (&acc)[2][2][4][2], const Unit& u, int wr, int wc, int fr, int fq) const {
        EPI_HEAD
        EPI_ROWS( float* op = O + row * ldo + col; *(f32x4*)op = v0; *(f32x4*)(op + 4) = v1; )
    }
};
struct EpiPle {
    static constexpr bool PERM = true, AFTER_DRAIN = false; static constexpr int MIDK = 0;
    const float* X; const float* P; float* Y; int ldx;
    __device__ __forceinline__ void operator()(const f32x4 (&acc)[2][2][4][2], const Unit& u, int wr, int wc, int fr, int fq) const {
        EPI_HEAD
        EPI_ROWS( const float* xp = X + row * ldx + col; const float* pp = P + row * ldx + col; float* yp = Y + row * ldx + col;
                  const f32x4 x0 = *(const f32x4*)xp, x1 = *(const f32x4*)(xp + 4), p0 = *(const f32x4*)pp, p1 = *(const f32x4*)(pp + 4);
                  *(f32x4*)yp = x0 + sigm4(v0) * p0; *(f32x4*)(yp + 4) = x1 + sigm4(v1) * p1; )
    }
};

#define EPI_SSQ(SSQ_, ss_) do { float _s = (ss_); _s += __shfl_xor(_s, 16); _s += __shfl_xor(_s, 32); if (fq == 0) (SSQ_)[row * 64 + u.pn * 4 + wc] = _s; } while (0)
__device__ __forceinline__ float dot4(f32x4 a) { return (a[0] * a[0] + a[1] * a[1]) + (a[2] * a[2] + a[3] * a[3]); }
template <bool XF32, bool RS = false> struct EpiResidN {
    static constexpr bool PERM = true, AFTER_DRAIN = false; static constexpr int MIDK = 0;
    const void* X; bf16_t* Y; int ldx; float* SSQ; const float* rstd;
    __device__ __forceinline__ void operator()(const f32x4 (&acc)[2][2][4][2], const Unit& u, int wr, int wc, int fr, int fq) const {
        EPI_HEAD
#pragma unroll
        for (int ai = 0; ai < 2; ++ai) {
            f32x4 xv[4][2][2]; float r2[4];
            if constexpr (RS) {
#pragma unroll
                for (int m = 0; m < 4; ++m) r2[m] = rstd[row0 + ai * HALF + m * 16];
            }
#pragma unroll
            for (int m = 0; m < 4; ++m)
#pragma unroll
                for (int bj = 0; bj < 2; ++bj) { const size_t row = (size_t)(row0 + ai * HALF + m * 16); const int col = col0 + bj * HALF;
                    if constexpr (XF32) { const float* xp = (const float*)X + row * ldx + col; xv[m][bj][0] = *(const f32x4*)xp; xv[m][bj][1] = *(const f32x4*)(xp + 4); }
                    else unpack8(*(const u32x4*)((const bf16_t*)X + kt_off(row, col, ldx)), xv[m][bj][0], xv[m][bj][1]); }
#pragma unroll
            for (int m = 0; m < 4; ++m) { const size_t row = (size_t)(row0 + ai * HALF + m * 16); float ss = 0.f;
#pragma unroll
                for (int bj = 0; bj < 2; ++bj) { const int col = col0 + bj * HALF;
                    f32x4 y0, y1; if constexpr (RS) { const float q = r2[m] * r2[m]; y0 = xv[m][bj][0] + acc[ai][bj][m][0] * q; y1 = xv[m][bj][1] + acc[ai][bj][m][1] * q; } else { y0 = xv[m][bj][0] + acc[ai][bj][m][0]; y1 = xv[m][bj][1] + acc[ai][bj][m][1]; }
                    *(u32x4*)(Y + kt_off(row, col, ldx)) = pack8(y0, y1); ss += dot4(y0) + dot4(y1); }
                EPI_SSQ(SSQ, ss); }
            asm volatile("" ::: "memory"); }
    }
};
struct EpiRelu2S {
    static constexpr bool PERM = true, AFTER_DRAIN = false; static constexpr int MIDK = 0;
    bf16_t* O; int ldo;
    __device__ __forceinline__ void operator()(const f32x4 (&acc)[2][2][4][2], const Unit& u, int wr, int wc, int fr, int fq) const {
        EPI_HEAD
#pragma unroll
        for (int ai = 0; ai < 2; ++ai)
#pragma unroll
            for (int m = 0; m < 4; ++m) { const size_t row = (size_t)(row0 + ai * HALF + m * 16);
#pragma unroll
                for (int bj = 0; bj < 2; ++bj) { const int col = col0 + bj * HALF; const f32x4 z = {0.f, 0.f, 0.f, 0.f};
                    const f32x4 r0 = __builtin_elementwise_max(acc[ai][bj][m][0], z), r1 = __builtin_elementwise_max(acc[ai][bj][m][1], z);
                    __builtin_nontemporal_store(pack8(r0 * r0, r1 * r1), (u32x4*)(O + kt_off(row, col, ldo))); } }
    }
};
struct EpiF32N {
    static constexpr bool PERM = true, AFTER_DRAIN = false; static constexpr int MIDK = 0;
    bf16_t* O; int ldo; float* SSQ;
    __device__ __forceinline__ void operator()(const f32x4 (&acc)[2][2][4][2], const Unit& u, int wr, int wc, int fr, int fq) const {
        EPI_HEAD
#pragma unroll
        for (int ai = 0; ai < 2; ++ai)
#pragma unroll
            for (int m = 0; m < 4; ++m) { const size_t row = (size_t)(row0 + ai * HALF + m * 16); float ss = 0.f;
#pragma unroll
                for (int bj = 0; bj < 2; ++bj) { const int col = col0 + bj * HALF; const f32x4 v0 = acc[ai][bj][m][0], v1 = acc[ai][bj][m][1];
                    *(u32x4*)(O + row * ldo + col) = pack8(v0, v1); ss += dot4(v0) + dot4(v1); }
                EPI_SSQ(SSQ, ss);
                asm volatile("" ::: "memory"); }
    }
};
struct EpiPleN {
    static constexpr bool PERM = true, AFTER_DRAIN = false; static constexpr int MIDK = 0;
    const bf16_t* X; const bf16_t* P; bf16_t* Y; int ldx; const float* rstd; const float* rstdp; const float* gp;
    __device__ __forceinline__ void operator()(const f32x4 (&acc)[2][2][4][2], const Unit& u, int wr, int wc, int fr, int fq) const {
        EPI_HEAD
        f32x4 gv[2][2]; float rs[2][4], rp[2][4];
#pragma unroll
        for (int bj = 0; bj < 2; ++bj) { gv[bj][0] = *(const f32x4*)(gp + col0 + bj * HALF); gv[bj][1] = *(const f32x4*)(gp + col0 + bj * HALF + 4); }
#pragma unroll
        for (int ai = 0; ai < 2; ++ai)
#pragma unroll
            for (int m = 0; m < 4; ++m) { rs[ai][m] = rstd[row0 + ai * HALF + m * 16]; rp[ai][m] = rstdp[row0 + ai * HALF + m * 16]; }
#pragma unroll
        for (int ai = 0; ai < 2; ++ai)
#pragma unroll
          for (int mh = 0; mh < 2; ++mh) {
            u32x4 wp[2][2], wx[2][2];
#pragma unroll
            for (int mm = 0; mm < 2; ++mm)
#pragma unroll
                for (int bj = 0; bj < 2; ++bj) { const int m = 2 * mh + mm; const size_t row = (size_t)(row0 + ai * HALF + m * 16); const int col = col0 + bj * HALF; wp[mm][bj] = *(const u32x4*)(P + row * ldx + col); wx[mm][bj] = *(const u32x4*)(X + kt_off(row, col, ldx)); }
#pragma unroll
            for (int mm = 0; mm < 2; ++mm)
#pragma unroll
                for (int bj = 0; bj < 2; ++bj) { const int m = 2 * mh + mm; const size_t row = (size_t)(row0 + ai * HALF + m * 16); const int col = col0 + bj * HALF; f32x4 p0, p1, x0, x1; unpack8(wp[mm][bj], p0, p1); unpack8(wx[mm][bj], x0, x1); const float s = rs[ai][m], q = rp[ai][m];
                    *(u32x4*)(Y + row * ldx + col) = pack8(x0 + sigm4(acc[ai][bj][m][0] * s) * (p0 * q * gv[bj][0]), x1 + sigm4(acc[ai][bj][m][1] * s) * (p1 * q * gv[bj][1])); }
            asm volatile("" ::: "memory"); }
    }
};

struct EpiMerge {
    static constexpr bool PERM = true, AFTER_DRAIN = false; static constexpr int MIDK = 32;
    const bf16_t* GA; const bf16_t* GB; int ldg; bf16_t* O; int ldo;
    __device__ __forceinline__ void mid(f32x4 (&acc)[2][2][4][2], const Unit& u, int wr, int wc, int fr, int fq) const {
        const bf16_t* ga = GA + (size_t)(u.pm * BM + wr * 64 + fr) * ldg + u.pn * BM + wc * 32 + 8 * fq; const size_t gd = GB - GA;
#pragma unroll
        for (int ai = 0; ai < 2; ++ai) {
            u32x4 wa[4][2], wb[4][2];
#pragma unroll
            for (int m = 0; m < 4; ++m)
#pragma unroll
                for (int bj = 0; bj < 2; ++bj) { const bf16_t* p = ga + (size_t)(ai * HALF + m * 16) * ldg + bj * HALF; wa[m][bj] = *(const u32x4*)p; wb[m][bj] = *(const u32x4*)(p + gd); }
#pragma unroll
            for (int m = 0; m < 4; ++m)
#pragma unroll
                for (int bj = 0; bj < 2; ++bj) { f32x4 a0, a1, b0, b1; unpack8(wa[m][bj], a0, a1); unpack8(wb[m][bj], b0, b1);
#pragma unroll
                    for (int q = 0; q < 4; ++q) { acc[ai][bj][m][0][q] *= (1.0f + __builtin_amdgcn_exp2f(-1.4426950408889634f * a0[q])) * sigm(b0[q]); acc[ai][bj][m][1][q] *= (1.0f + __builtin_amdgcn_exp2f(-1.4426950408889634f * a1[q])) * sigm(b1[q]); } }
            asm volatile("" ::: "memory"); }
    }
    __device__ __forceinline__ void operator()(const f32x4 (&acc)[2][2][4][2], const Unit& u, int wr, int wc, int fr, int fq) const {
        EPI_HEAD
#pragma unroll
        for (int ai = 0; ai < 2; ++ai) {
            u32x4 wa[4][2];
#pragma unroll
            for (int m = 0; m < 4; ++m)
#pragma unroll
                for (int bj = 0; bj < 2; ++bj) wa[m][bj] = *(const u32x4*)(GA + (size_t)(row0 + ai * HALF + m * 16) * ldg + col0 + bj * HALF);
#pragma unroll
            for (int m = 0; m < 4; ++m)
#pragma unroll
                for (int bj = 0; bj < 2; ++bj) { f32x4 g0, g1; unpack8(wa[m][bj], g0, g1); *(u32x4*)(O + kt_off((size_t)(row0 + ai * HALF + m * 16), col0 + bj * HALF, ldo)) = pack8(sigm4(g0) * acc[ai][bj][m][0], sigm4(g1) * acc[ai][bj][m][1]); }
            asm volatile("" ::: "memory"); }
    }
};

struct SegOrder : StaticOrder {
    __device__ bool next(int i, Unit& u) const { const bool r = StaticOrder::next(i >> 1, u); u.seg = i & 1; return r; }
};
template <class Epi, class Sched, bool ALIGN_EPI = false, bool SP2 = false>
__device__ __forceinline__ void gemm_phase(PG8_LAS unsigned char* lds, const Gemm g, const Sched& S, const Epi& E) {
    const int tid = otid(), wid = __builtin_amdgcn_readfirstlane(tid >> 6), lane = tid & 63, wr = wid >> 2, wc = wid & 3, fr = lane & 15, fq = lane >> 4;
    const int K = g.K, nt = K / BK;
    constexpr bool SEG = Epi::MIDK > 0;
#define PG8_KOFF(u_) ((SEG && (u_).seg) ? (size_t)Epi::MIDK * HTB : (size_t)0)
#define PG8_NT(u_) (SEG ? ((u_).seg ? nt - Epi::MIDK : Epi::MIDK) : nt)
    unsigned voffA[2], voffB[2];
#pragma unroll
    for (int i = 0; i < 2; ++i) { int R, C; stage_rc(tid * 16 + i * 8192, R, C); const int Rb = Epi::PERM ? ((R & ~31) + perm32(R & 31)) : R;
        voffA[i] = (unsigned)(R * BK + C) * 2u; voffB[i] = (unsigned)(Rb * BK + C) * 2u; }
    const size_t kstep = (size_t)HTB;
    const size_t hstep = (size_t)(g.ld / BK) * HTB;
    const size_t tstep = 2 * hstep;
    const unsigned ldsw = (unsigned)wid * 1024u;
    const int aoff = lds_byte(wr * 64 + fr, fq * 8), boff = lds_byte(wc * 32 + fr, fq * 8);
#define PG8_SA(b, h) (((b) * 2 + (h)) * HTB)
#define PG8_SB(b, h) ((4 + (b) * 2 + (h)) * HTB)
#define PG8_STAGE(bufoff, gbase, voff) do { _Pragma("unroll") for (int _i = 0; _i < 2; ++_i) \
        __builtin_amdgcn_global_load_lds((const unsigned*)((const char*)(gbase) + (voff)[_i]), (PG8_LAS unsigned*)(lds + (bufoff) + ldsw + _i * 8192), 16, 0, 0); } while (0)
#define PG8_LDA(dst, b, h) do { _Pragma("unroll") for (int m = 0; m < 4; ++m) _Pragma("unroll") for (int k = 0; k < 2; ++k) dst[m][k] = *(const PG8_LAS bf16x8*)(lds + PG8_SA(b, h) + aoff + m * 2048 + k * 1024); } while (0)
#define PG8_LDB(dst, b, h) do { _Pragma("unroll") for (int n = 0; n < 2; ++n) _Pragma("unroll") for (int k = 0; k < 2; ++k) dst[n][k] = *(const PG8_LAS bf16x8*)(lds + PG8_SB(b, h) + boff + n * 2048 + k * 1024); } while (0)
#define PG8_MMA(ai, bj, At, Bt) do { __builtin_amdgcn_s_setprio(1); _Pragma("unroll") for (int m = 0; m < 4; ++m) _Pragma("unroll") for (int n = 0; n < 2; ++n) _Pragma("unroll") for (int k = 0; k < 2; ++k) \
        acc[ai][bj][m][n] = __builtin_amdgcn_mfma_f32_16x16x32_bf16(Bt[n][k], At[m][k], acc[ai][bj][m][n], 0, 0, 0); __builtin_amdgcn_s_setprio(0); } while (0)
#define PG8_WAIT_V(n) asm volatile("s_waitcnt vmcnt(" #n ")" ::: "memory")
#define PG8_WAIT_L(n) asm volatile("s_waitcnt lgkmcnt(" #n ")" ::: "memory")
#define PG8_BAR __builtin_amdgcn_s_barrier()
#define PG8_SCHED __builtin_amdgcn_sched_barrier(0)
    Unit cur, nxt; int ui = 0;
    if (!S.next(0, cur)) return;
    f32x4 acc[2][2][4][2];
#pragma unroll
    for (int a = 0; a < 2; ++a)
#pragma unroll
        for (int b = 0; b < 2; ++b)
#pragma unroll
            for (int m = 0; m < 4; ++m)
#pragma unroll
                for (int n = 0; n < 2; ++n) acc[a][b][m][n] = (f32x4){0.f, 0.f, 0.f, 0.f};
    bf16x8 At[4][2], B0[2][2], B1[2][2];
    const char* cA = (const char*)g.A + (size_t)cur.pm * tstep + PG8_KOFF(cur); const char* cB = (const char*)g.Bt + (size_t)cur.pn * tstep + PG8_KOFF(cur);
    S.a_ready(cur);
    if constexpr (SP2) {
        PG8_STAGE(PG8_SB(0, 0), cB, voffB); PG8_STAGE(PG8_SB(0, 1), cB + hstep, voffB); PG8_STAGE(PG8_SA(0, 0), cA, voffA); PG8_STAGE(PG8_SA(0, 1), cA + hstep, voffA);
        if (wr == 1) PG8_BAR;
        PG8_WAIT_V(2); PG8_BAR;
        PG8_STAGE(PG8_SB(1, 0), cB + kstep, voffB); PG8_STAGE(PG8_SA(1, 0), cA + kstep, voffA); PG8_STAGE(PG8_SB(1, 1), cB + hstep + kstep, voffB);
        PG8_WAIT_V(6); PG8_BAR;
    } else {
        PG8_STAGE(PG8_SB(0, 0), cB, voffB); PG8_STAGE(PG8_SA(0, 0), cA, voffA); PG8_STAGE(PG8_SB(0, 1), cB + hstep, voffB); PG8_STAGE(PG8_SA(0, 1), cA + hstep, voffA);
        if (wr == 1) PG8_BAR;
        PG8_WAIT_V(4); PG8_BAR;
        PG8_STAGE(PG8_SB(1, 0), cB + kstep, voffB); PG8_STAGE(PG8_SA(1, 0), cA + kstep, voffA); PG8_STAGE(PG8_SB(1, 1), cB + hstep + kstep, voffB);
        PG8_WAIT_V(6); PG8_BAR;
    }
    for (;;) {
        const bool has_next = S.next(ui + 1, nxt);
        const char* nA = has_next ? (const char*)g.A + (size_t)nxt.pm * tstep + PG8_KOFF(nxt) : cA; const char* nB = has_next ? (const char*)g.Bt + (size_t)nxt.pn * tstep + PG8_KOFF(nxt) : cB;
        const int ntu = PG8_NT(cur);
        for (int t = 0; t < ntu; t += 2) {
            const bool last = (t == ntu - 2);
            const char* a1 = cA + (size_t)(t + 1) * kstep;
            const char* a2 = last ? nA : cA + (size_t)(t + 2) * kstep; const char* b2 = last ? nB : cB + (size_t)(t + 2) * kstep;
            const char* a3 = a2 + kstep; const char* b3 = b2 + kstep;
            if (last && has_next) S.a_ready(nxt);
            if constexpr (SP2) {
            PG8_LDB(B0, 0, 0); PG8_LDB(B1, 0, 1); PG8_SCHED; PG8_LDA(At, 0, 0); PG8_STAGE(PG8_SA(1, 1), a1 + hstep, voffA);
            PG8_WAIT_V(8); PG8_WAIT_L(0); PG8_BAR; PG8_MMA(0, 0, At, B0); PG8_MMA(0, 1, At, B1); PG8_BAR; PG8_SCHED;
            PG8_LDA(At, 0, 1); PG8_STAGE(PG8_SB(0, 0), b2, voffB); PG8_STAGE(PG8_SB(0, 1), b2 + hstep, voffB); PG8_STAGE(PG8_SA(0, 0), a2, voffA);
            PG8_WAIT_V(8); PG8_WAIT_L(0); PG8_BAR; PG8_MMA(1, 0, At, B0); PG8_MMA(1, 1, At, B1); PG8_BAR; PG8_SCHED;
            PG8_LDB(B0, 1, 0); PG8_LDB(B1, 1, 1); PG8_SCHED; PG8_LDA(At, 1, 0); PG8_STAGE(PG8_SA(0, 1), a2 + hstep, voffA);
            PG8_WAIT_V(8); PG8_WAIT_L(0); PG8_BAR; PG8_MMA(0, 0, At, B0); PG8_MMA(0, 1, At, B1); PG8_BAR; PG8_SCHED;
            PG8_LDA(At, 1, 1); PG8_STAGE(PG8_SB(1, 0), b3, voffB); PG8_STAGE(PG8_SB(1, 1), b3 + hstep, voffB); PG8_STAGE(PG8_SA(1, 0), a3, voffA);
            PG8_WAIT_V(8); PG8_WAIT_L(0); PG8_BAR; PG8_MMA(1, 0, At, B0); PG8_MMA(1, 1, At, B1); PG8_BAR; PG8_SCHED;
            } else {
            PG8_LDB(B0, 0, 0); PG8_SCHED; PG8_LDA(At, 0, 0); PG8_STAGE(PG8_SA(1, 1), a1 + hstep, voffA);
            PG8_WAIT_L(8); PG8_BAR; PG8_WAIT_L(0); PG8_MMA(0, 0, At, B0); PG8_BAR; PG8_SCHED;
            PG8_LDB(B1, 0, 1); PG8_STAGE(PG8_SB(0, 0), b2, voffB);
            PG8_BAR; PG8_WAIT_L(0); PG8_MMA(0, 1, At, B1); PG8_BAR;
            PG8_LDA(At, 0, 1); PG8_STAGE(PG8_SA(0, 0), a2, voffA);
            PG8_BAR; PG8_WAIT_L(0); PG8_MMA(1, 0, At, B0); PG8_BAR; PG8_SCHED;
            PG8_STAGE(PG8_SB(0, 1), b2 + hstep, voffB);
            PG8_WAIT_V(6); PG8_BAR; PG8_MMA(1, 1, At, B1); PG8_BAR;
            PG8_LDB(B0, 1, 0); PG8_SCHED; PG8_LDA(At, 1, 0); PG8_STAGE(PG8_SA(0, 1), a2 + hstep, voffA);
            PG8_WAIT_L(8); PG8_BAR; PG8_WAIT_L(0); PG8_MMA(0, 0, At, B0); PG8_BAR; PG8_SCHED;
            PG8_LDB(B1, 1, 1); PG8_STAGE(PG8_SB(1, 0), b3, voffB);
            PG8_BAR; PG8_WAIT_L(0); PG8_MMA(0, 1, At, B1); PG8_BAR;
            PG8_LDA(At, 1, 1); PG8_STAGE(PG8_SA(1, 0), a3, voffA);
            PG8_BAR; PG8_WAIT_L(0); PG8_MMA(1, 0, At, B0); PG8_BAR; PG8_SCHED;
            PG8_STAGE(PG8_SB(1, 1), b3 + hstep, voffB);
            PG8_WAIT_V(6); PG8_BAR; PG8_MMA(1, 1, At, B1); PG8_BAR;
            }
        }
        if constexpr (ALIGN_EPI) { if (wr == 0) PG8_BAR; }
        if constexpr (SEG) { if (cur.seg == 0) E.mid(acc, cur, wr, wc, fr, fq); else E(acc, cur, wr, wc, fr, fq); }
        else if constexpr (!Epi::AFTER_DRAIN) { E(acc, cur, wr, wc, fr, fq); S.done(cur); }
        if (!has_next) break;
        if (!(SEG && cur.seg == 0))
#pragma unroll
        for (int a = 0; a < 2; ++a)
#pragma unroll
            for (int b = 0; b < 2; ++b)
#pragma unroll
                for (int m = 0; m < 4; ++m)
#pragma unroll
                    for (int n = 0; n < 2; ++n) acc[a][b][m][n] = (f32x4){0.f, 0.f, 0.f, 0.f};
        cur = nxt; cA = nA; cB = nB; ++ui;
        if constexpr (ALIGN_EPI) { if (wr == 1) PG8_BAR; }
    }
    PG8_WAIT_V(0);
    if constexpr (!ALIGN_EPI) { if (wr == 0) PG8_BAR; }
    PG8_BAR;
    if constexpr (Epi::AFTER_DRAIN) { E.fused(acc, cur, wr, wc, fr, fq, lds, wid, lane); S.done(cur); }
#undef PG8_SA
#undef PG8_SB
#undef PG8_STAGE
#undef PG8_LDA
#undef PG8_LDB
#undef PG8_MMA
#undef PG8_WAIT_V
#undef PG8_WAIT_L
#undef PG8_BAR
#undef PG8_SCHED
#undef PG8_KOFF
#undef PG8_NT
}
}

namespace swa {
constexpr int D = 128; constexpr float THR = 8.f; constexpr bool WSKIP = true;
constexpr float SCALE = 0.08838834764831845f;
constexpr int NW = 8, QBLK = 32, KVBLK = 64, QB = NW * QBLK;
constexpr int SHM_V = KVBLK * D * 2, SHM_K = KVBLK * D * 2;
constexpr int LDS_BYTES = 2 * SHM_V + 2 * SHM_K + NW * 64 * 4;

typedef unsigned short bf16;
typedef short bf16x8 __attribute__((ext_vector_type(8)));
typedef short s16x4 __attribute__((ext_vector_type(4)));
typedef float f32x16 __attribute__((ext_vector_type(16)));
typedef float f32x4 __attribute__((ext_vector_type(4)));
typedef unsigned u32x4 __attribute__((ext_vector_type(4)));
template <class A, class Bt> struct same_t { static constexpr bool v = false; };
template <class A> struct same_t<A, A> { static constexpr bool v = true; };

#define KSWZ(row, colB) ((row) * 256 + ((colB) ^ (((row) & 7) << 4)))
#define SBAR() __builtin_amdgcn_sched_barrier(0)
__device__ __forceinline__ int v_st(int k, int c) { const int kk = (k & ~0xC) | ((k & 4) << 1) | ((k & 8) >> 1); return ((kk >> 3) * 4 + (c >> 5)) * 512 + ((kk & 7) * 32 + (c & 31)) * 2; }
__device__ __forceinline__ int v_rd_base(int lane) { return ((lane & 3) << 3) | (((lane >> 2) & 3) << 6) | (((lane >> 4) & 1) << 5) | (((lane >> 5) & 1) << 8); }
constexpr int v_rd_off(int d0, int ks, int half) { return d0 * 512 + ks * 4096 + half * 2048; }
__device__ __forceinline__ int crow(int r, int hi) { return (r & 3) + 8 * (r >> 2) + 4 * hi; }
typedef float f32x2_t __attribute__((ext_vector_type(2))); typedef __bf16 bf16x2_t __attribute__((ext_vector_type(2)));
__device__ __forceinline__ unsigned cvtpk(float lo, float hi) { const f32x2_t v = {lo, hi}; const bf16x2_t b = __builtin_convertvector(v, bf16x2_t); return __builtin_bit_cast(unsigned, b); }
__device__ __forceinline__ bf16x8 pack8(f32x4 a, f32x4 b) {
    u32x4 w = {cvtpk(a[0], a[1]), cvtpk(a[2], a[3]), cvtpk(b[0], b[1]), cvtpk(b[2], b[3])};
    return *reinterpret_cast<bf16x8*>(&w);
}
template <class T> __device__ __forceinline__ bf16x8 load8(const T* p) {
    if constexpr (same_t<T, float>::v) { return pack8(*(const f32x4*)p, *(const f32x4*)(p + 4)); }
    else { return *reinterpret_cast<const bf16x8*>(p); }
}
__device__ __forceinline__ void mask_tile(f32x16& p0, f32x16& p1, int dq, unsigned W) {
    const float NEG = -__builtin_inff();
#pragma unroll
    for (int r = 0; r < 16; ++r) {
        const int c = (r & 3) + 8 * (r >> 2);
        if ((unsigned)(dq - c) >= W) p0[r] = NEG;
        if ((unsigned)(dq - c - 32) >= W) p1[r] = NEG;
    }
}
__device__ __forceinline__ void partialSM(f32x16& p0, f32x16& p1, float& m_reg, float& mn, float& alpha) {
    float pmax = p0[0]; for (int r = 1; r < 16; ++r) pmax = fmaxf(pmax, p0[r]); for (int r = 0; r < 16; ++r) pmax = fmaxf(pmax, p1[r]);
    { auto rr = __builtin_amdgcn_permlane32_swap(__float_as_uint(pmax), __float_as_uint(pmax), false, false);
      pmax = fmaxf(__uint_as_float(rr[0]), __uint_as_float(rr[1])); }
    constexpr float C2 = 1.4426950408889634f * SCALE;
    if (__builtin_expect(__all((pmax - m_reg) * SCALE <= THR), 1)) { mn = m_reg; alpha = 1.f; }
    else { mn = fmaxf(m_reg, pmax); alpha = __builtin_amdgcn_exp2f((m_reg - mn) * C2); m_reg = mn; }
    const float mnL = -mn * C2;
    for (int r = 0; r < 16; ++r) p0[r] = fmaf(p0[r], C2, mnL); for (int r = 0; r < 16; ++r) p1[r] = fmaf(p1[r], C2, mnL);
    for (int r = 0; r < 16; ++r) p0[r] = __builtin_amdgcn_exp2f(p0[r]);
}
__device__ __forceinline__ void finishSM(f32x16& p0, f32x16& p1, float alpha, float& l_reg, bf16x8& pa0, bf16x8& pa1, bf16x8& pa2, bf16x8& pa3) {
    for (int r = 0; r < 16; ++r) p1[r] = __builtin_amdgcn_exp2f(p1[r]);
    float ps = 0; for (int r = 0; r < 16; ++r) ps += p0[r]; for (int r = 0; r < 16; ++r) ps += p1[r];
    { auto rr = __builtin_amdgcn_permlane32_swap(__float_as_uint(ps), __float_as_uint(ps), false, false);
      ps = __uint_as_float(rr[0]) + __uint_as_float(rr[1]); }
    l_reg = l_reg * alpha + ps;
#define PK4(P, B_, OUT) do { unsigned a0 = cvtpk(P[B_+0], P[B_+1]), a1 = cvtpk(P[B_+2], P[B_+3]);                          \
        unsigned b0 = cvtpk(P[B_+4], P[B_+5]), b1 = cvtpk(P[B_+6], P[B_+7]);                                             \
        auto r0 = __builtin_amdgcn_permlane32_swap(a0, b0, false, false); auto r1 = __builtin_amdgcn_permlane32_swap(a1, b1, false, false); \
        u32x4 w = {r0[0], r1[0], r0[1], r1[1]}; OUT = *reinterpret_cast<bf16x8*>(&w); } while (0)
    PK4(p0, 0, pa0); PK4(p0, 8, pa1); PK4(p1, 0, pa2); PK4(p1, 8, pa3);
#undef PK4
}
template <int KB, bool SK>
__device__ __forceinline__ void qkt(f32x16& p0, f32x16& p1, const char* K_lds, int r32, int hi, const bf16x8* qr, bool act) {
    if (SK && !act) { const float NEG = -__builtin_inff();
#pragma unroll
        for (int r = 0; r < 16; ++r) { p0[r] = NEG; p1[r] = NEG; } return; }
    p0 = f32x16{}; p1 = f32x16{};
    const char* kb[4];
#pragma unroll
    for (int dd = 0; dd < 4; ++dd) kb[dd] = K_lds + KB * SHM_K + KSWZ(r32, (dd * 16 + hi * 8) * 2);
#pragma unroll
    for (int d0 = 0; d0 < 8; ++d0) { const char* a = kb[d0 & 3] + (d0 >> 2) * 128;
        bf16x8 b0 = *reinterpret_cast<const bf16x8*>(a);
        bf16x8 b1 = *reinterpret_cast<const bf16x8*>(a + 32 * 256);
        p0 = __builtin_amdgcn_mfma_f32_32x32x16_bf16(b0, qr[d0], p0, 0, 0, 0);
        p1 = __builtin_amdgcn_mfma_f32_32x32x16_bf16(b1, qr[d0], p1, 0, 0, 0); }
}
template <int VB, bool SK>
__device__ __forceinline__ void pv_tile(f32x16* o, int vb0, bf16x8 pa0, bf16x8 pa1, bf16x8 pa2, bf16x8 pa3, bool act) {
    if (SK && !act) return;
#define TRRD(dst, off) asm volatile("ds_read_b64_tr_b16 %0, %1 offset:%2" : "=&v"(dst) : "v"(vb0), "i"(off) : "memory")
#define PV_D0(d0) do { s16x4 l0, l1, l2, l3, h0, h1, h2, h3; constexpr int b_ = VB * SHM_V + v_rd_off(d0, 0, 0);     \
        TRRD(l0, b_); TRRD(h0, b_ + 2048); TRRD(l1, b_ + 4096); TRRD(h1, b_ + 6144); TRRD(l2, b_ + 8192); TRRD(h2, b_ + 10240); TRRD(l3, b_ + 12288); TRRD(h3, b_ + 14336); \
        asm volatile("s_waitcnt lgkmcnt(0)" ::: "memory"); SBAR();                 \
        o[d0] = __builtin_amdgcn_mfma_f32_32x32x16_bf16(pa0, (bf16x8){l0[0], l0[1], l0[2], l0[3], h0[0], h0[1], h0[2], h0[3]}, o[d0], 0, 0, 0);   \
        o[d0] = __builtin_amdgcn_mfma_f32_32x32x16_bf16(pa1, (bf16x8){l1[0], l1[1], l1[2], l1[3], h1[0], h1[1], h1[2], h1[3]}, o[d0], 0, 0, 0);   \
        o[d0] = __builtin_amdgcn_mfma_f32_32x32x16_bf16(pa2, (bf16x8){l2[0], l2[1], l2[2], l2[3], h2[0], h2[1], h2[2], h2[3]}, o[d0], 0, 0, 0);   \
        o[d0] = __builtin_amdgcn_mfma_f32_32x32x16_bf16(pa3, (bf16x8){l3[0], l3[1], l3[2], l3[3], h3[0], h3[1], h3[2], h3[3]}, o[d0], 0, 0, 0); } while (0)
    PV_D0(0); PV_D0(1); PV_D0(2); PV_D0(3);
#undef PV_D0
#undef TRRD
}

template <class TIn, class TOut> struct BlockRef { const TIn* Q; const TIn* K; const TIn* V; TOut* O; float* LSE; int P0, rs, ors, lrs; };
template <class TIn> struct Seam {
    bf16x8 qr[8];
    bf16x8 st_v0, st_v1, st_k0, st_k1; f32x4 sf0, sf1, sf2, sf3;
    f32x4 tq[16];
};
__device__ __forceinline__ int swa_jlo(int P0, int W) { const int lowk = P0 - W + 1; return lowk > 0 ? lowk / KVBLK : 0; }
#define ROW(p, k0, rr, RS_) ((p) + (size_t)((k0) + (rr)) * (RS_) + sc)
#define VMW() asm volatile("s_waitcnt vmcnt(0)" ::: "memory")
#define VMWN(n) asm volatile("s_waitcnt vmcnt(%0)" :: "i"(n) : "memory")
#define SLOAD_H(Kp, Vp, k0, RS_) do { S.st_v0 = load8<TIn>(ROW(Vp, k0, sr, RS_)); S.st_v1 = load8<TIn>(ROW(Vp, k0, 32 + sr, RS_));              \
                         S.st_k0 = load8<TIn>(ROW(Kp, k0, sr, RS_)); S.st_k1 = load8<TIn>(ROW(Kp, k0, 32 + sr, RS_)); } while (0)
#define SWRITE_HK(bf) do { *(bf16x8*)(K_lds + (bf) * SHM_K + kws) = S.st_k0; *(bf16x8*)(K_lds + (bf) * SHM_K + kws + 32 * 256) = S.st_k1; } while (0)
#define SWRITE_HV(bf) do { *(bf16x8*)(V_lds + (bf) * SHM_V + vst0) = S.st_v0; *(bf16x8*)(V_lds + (bf) * SHM_V + vst1) = S.st_v1; } while (0)
#define SWRITE_H(bf) do { SWRITE_HV(bf); SWRITE_HK(bf); } while (0)
#define SLOAD_F(p, k0, RS_) do { S.sf0 = *(const f32x4*)ROW(p, k0, sr, RS_); S.sf1 = *(const f32x4*)(ROW(p, k0, sr, RS_) + 4);                \
                            S.sf2 = *(const f32x4*)ROW(p, k0, 32 + sr, RS_); S.sf3 = *(const f32x4*)(ROW(p, k0, 32 + sr, RS_) + 4); } while (0)
#define SWRITE_KF(bf) do { *(bf16x8*)(K_lds + (bf) * SHM_K + kws) = pack8(S.sf0, S.sf1); *(bf16x8*)(K_lds + (bf) * SHM_K + kws + 32 * 256) = pack8(S.sf2, S.sf3); } while (0)
#define SWRITE_VF(bf) do { *(bf16x8*)(V_lds + (bf) * SHM_V + vst0) = pack8(S.sf0, S.sf1); *(bf16x8*)(V_lds + (bf) * SHM_V + vst1) = pack8(S.sf2, S.sf3); } while (0)
template <class TIn, class TOut>
__device__ __forceinline__ void causal_swa_prime(const BlockRef<TIn, TOut>& cur, int W, char* lds, Seam<TIn>& S) {
    constexpr bool F32 = same_t<TIn, float>::v;
    const int tid = otid(), wid = __builtin_amdgcn_readfirstlane(tid >> 6), lane = tid & 63, r32 = lane & 31, hi = lane >> 5;
    const int sr = tid >> 4, sc = (tid & 15) * 8, kws = KSWZ(sr, sc * 2); char* K_lds = lds + 2 * SHM_V;
    const int kb0 = swa_jlo(cur.P0, W) * KVBLK;
    for (int d0 = 0; d0 < 8; ++d0) S.qr[d0] = load8<TIn>(cur.Q + (size_t)(wid * QBLK + r32) * cur.rs + d0 * 16 + hi * 8);
    if constexpr (F32) { SLOAD_F((const float*)cur.K, kb0, cur.rs); VMW(); SWRITE_KF(0); SBAR(); SLOAD_F((const float*)cur.V, kb0, cur.rs); }
    else { SLOAD_H(cur.K, cur.V, kb0, cur.rs); VMW(); SWRITE_HK(0); }
    __syncthreads();
}
template <class TIn, class TOut>
__device__ __forceinline__ void causal_swa_block(const BlockRef<TIn, TOut>& cur, const BlockRef<TIn, TOut>& nxt, int skv, int W, char* lds, Seam<TIn>& S) {
    constexpr bool F32 = same_t<TIn, float>::v;
    const int tid = otid(), wid = __builtin_amdgcn_readfirstlane(tid >> 6), lane = tid & 63, r32 = lane & 31, hi = lane >> 5;
    const int j_lo = swa_jlo(cur.P0, W);
    int j_hi = (cur.P0 + QB - 1) / KVBLK + 1; if (j_hi > skv / KVBLK) j_hi = skv / KVBLK;
    const int NT = j_hi - j_lo;
    const int kbn = swa_jlo(nxt.P0, W) * KVBLK;
    const int qlo = cur.P0 + wid * QBLK, qm = qlo + r32 - 4 * hi;
    char* V_lds = lds; char* K_lds = lds + 2 * SHM_V;
    float* ws = (float*)(lds + 2 * SHM_V + 2 * SHM_K) + wid * 64; float* li_l = ws, * al_l = ws + 32;
    float m_reg = -1e30f, l_reg = 0; f32x16 o[4] = {};
    const int sr = tid >> 4, sc = (tid & 15) * 8, vst0 = v_st(sr, sc), vst1 = v_st(32 + sr, sc), kws = KSWZ(sr, sc * 2);
    const int vb0 = (int)(uintptr_t)V_lds + v_rd_base(lane);
    const TIn* Kh = cur.K; const TIn* Vh = cur.V;
#define RESC(a) do { if (__any((a) < 1.f)) { if (hi == 0) al_l[r32] = (a); asm volatile("s_waitcnt lgkmcnt(0)" ::: "memory");              \
                     for (int d_ = 0; d_ < 4; ++d_) for (int r = 0; r < 16; ++r) o[d_][r] *= al_l[crow(r, hi)]; } } while (0)
#define KBASE(t) ((j_lo + (t)) * KVBLK)
#define ACT(t) (KBASE(t) <= qlo + QBLK - 1 && KBASE(t) + KVBLK - 1 >= qlo - W + 1)
#define MASKT(P0_, P1_, t) do { const int kb_ = KBASE(t); if ((!SK || ACT(t)) && (kb_ + KVBLK - 1 > qlo || kb_ <= qlo + QBLK - 1 - W)) mask_tile(P0_, P1_, qm - kb_, (unsigned)W); } while (0)
    constexpr int NQL = F32 ? 16 : 8;
    constexpr bool SK = WSKIP && !F32;
#define SEAM_K0() do { VMWN(NQL); if constexpr (F32) { SWRITE_KF(0); SBAR(); SLOAD_F((const float*)nxt.V, kbn, nxt.rs); } else { SWRITE_HK(0); } SBAR(); } while (0)
    f32x16 pA0, pA1, pB0, pB1; float mnA, mnB, alA, alB; bf16x8 pa0, pa1, pa2, pa3;
    if constexpr (F32) { VMW(); SWRITE_VF(0); SBAR(); } else { SWRITE_HV(0); SBAR(); }
    if (NT > 1) { if constexpr (F32) SLOAD_F((const float*)Kh, KBASE(1), cur.rs); else SLOAD_H(Kh, Vh, KBASE(1), cur.rs); }
    SBAR(); qkt<0, SK>(pA0, pA1, K_lds, r32, hi, S.qr, ACT(0));
    if constexpr (F32) { if (NT > 1) { VMW(); SWRITE_KF(1); SBAR(); SLOAD_F((const float*)Vh, KBASE(1), cur.rs); } }
    MASKT(pA0, pA1, 0); partialSM(pA0, pA1, m_reg, mnA, alA);
    if (NT > 1) { VMW(); if constexpr (F32) { SWRITE_VF(1); SBAR(); if (NT > 2) SLOAD_F((const float*)Kh, KBASE(2), cur.rs); } else SWRITE_H(1); }
    __syncthreads();
#define HALF_STEP(PX0, PX1, mnX, alX, PY0, PY1, alY, t, KB, VB, SB) do {                                                      \
        SBAR(); qkt<KB, SK>(PX0, PX1, K_lds, r32, hi, S.qr, ACT(t));                                             \
        finishSM(PY0, PY1, alY, l_reg, pa0, pa1, pa2, pa3); SBAR();                                                           \
        if ((t) + 1 < NT) { if constexpr (F32) { VMW(); SWRITE_KF(SB); SBAR(); SLOAD_F((const float*)Vh, KBASE((t) + 1), cur.rs); }  \
                            else { SLOAD_H(Kh, Vh, KBASE((t) + 1), cur.rs); } SBAR(); }                                               \
        pv_tile<VB, SK>(o, vb0, pa0, pa1, pa2, pa3, ACT((t) - 1)); MASKT(PX0, PX1, (t)); partialSM(PX0, PX1, m_reg, mnX, alX);                                        \
        __syncthreads();                                                                                                      \
        if ((t) + 1 < NT) { VMW(); if constexpr (F32) { SWRITE_VF(SB); SBAR(); if ((t) + 2 < NT) SLOAD_F((const float*)Kh, KBASE((t) + 2), cur.rs); } \
                            else { SWRITE_H(SB); } }                                                                          \
        RESC(alX); __syncthreads(); } while (0)
    for (int t = 1; t + 1 < NT; t += 2) {
        HALF_STEP(pB0, pB1, mnB, alB, pA0, pA1, alA, t, 1, 0, 0);
        HALF_STEP(pA0, pA1, mnA, alA, pB0, pB1, alB, t + 1, 0, 1, 1);
    }
    const bool even = (NT & 1) == 0;
    if (even) { SBAR(); qkt<1, SK>(pB0, pB1, K_lds, r32, hi, S.qr, ACT(NT - 1)); SBAR(); }
#define QROW(e) (nxt.Q + (size_t)(wid * QBLK + r32) * nxt.rs + ((e) >> 1) * 16 + hi * 8 + ((e) & 1) * 4)
    if constexpr (F32) { SLOAD_F((const float*)nxt.K, kbn, nxt.rs); SBAR();
#pragma unroll
        for (int e = 0; e < 8; ++e) S.tq[e] = *(const f32x4*)QROW(e); }
    else { SLOAD_H(nxt.K, nxt.V, kbn, nxt.rs); SBAR();
#pragma unroll
        for (int d0 = 0; d0 < 8; ++d0) S.qr[d0] = load8<TIn>(nxt.Q + (size_t)(wid * QBLK + r32) * nxt.rs + d0 * 16 + hi * 8); }
    SBAR();
    finishSM(pA0, pA1, alA, l_reg, pa0, pa1, pa2, pa3); SBAR();
    if constexpr (F32) {
#pragma unroll
        for (int e = 8; e < 16; ++e) S.tq[e] = *(const f32x4*)QROW(e); SBAR(); }
#undef QROW
    pv_tile<0, SK>(o, vb0, pa0, pa1, pa2, pa3, ACT(even ? NT - 2 : NT - 1));
    if (even) { MASKT(pB0, pB1, NT - 1); partialSM(pB0, pB1, m_reg, mnB, alB); __syncthreads(); RESC(alB);
        finishSM(pB0, pB1, alB, l_reg, pa0, pa1, pa2, pa3); SBAR(); pv_tile<1, SK>(o, vb0, pa0, pa1, pa2, pa3, ACT(NT - 1)); }
    SBAR(); SEAM_K0();
    if (hi == 0) { li_l[r32] = l_reg; cur.LSE[(size_t)(wid * QBLK + r32) * cur.lrs] = m_reg * SCALE + __logf(l_reg); } asm volatile("s_waitcnt lgkmcnt(0)" ::: "memory");
    float rli[16];
#pragma unroll
    for (int r = 0; r < 16; ++r) rli[r] = __builtin_amdgcn_rcpf(li_l[crow(r, hi)]);
    TOut* Ow = cur.O + (size_t)(wid * QBLK) * cur.ors;
#pragma unroll
    for (int r = 0; r < 16; ++r) { const int orow = crow(r, hi);
#pragma unroll
        for (int d0 = 0; d0 < 4; ++d0) { const float v = o[d0][r] * rli[r];
            if constexpr (same_t<TOut, float>::v) { Ow[(size_t)orow * cur.ors + d0 * 32 + r32] = v; }
            else { const float vn = __shfl_xor(v, 1);
                   if ((r32 & 1) == 0) *(unsigned*)(Ow + (size_t)orow * cur.ors + d0 * 32 + r32) = cvtpk(v, vn); } } }
    if constexpr (F32) {
#pragma unroll
        for (int d0 = 0; d0 < 8; ++d0) S.qr[d0] = pack8(S.tq[2 * d0], S.tq[2 * d0 + 1]); }
    __syncthreads();
#undef RESC
#undef KBASE
#undef ACT
#undef MASKT
#undef SEAM_K0
#undef HALF_STEP
}
#undef ROW
#undef VMW
#undef VMWN
#undef SLOAD_H
#undef SWRITE_HK
#undef SWRITE_HV
#undef SWRITE_H
#undef SLOAD_F
#undef SWRITE_KF
#undef SWRITE_VF


}
#define GAS __attribute__((address_space(1)))
#define LAS __attribute__((address_space(3)))
typedef unsigned short bf16;
typedef unsigned v4u __attribute__((ext_vector_type(4)));
typedef float f32x4 __attribute__((ext_vector_type(4)));
typedef short bf16x8 __attribute__((ext_vector_type(8)));
typedef GAS unsigned gu32;
typedef GAS unsigned long long gu64;
#define RLX_AGENT __ATOMIC_RELAXED, __HIP_MEMORY_SCOPE_AGENT
#define LDS_WAIT() asm volatile("s_waitcnt lgkmcnt(0)" ::: "memory")
#define VM_WAIT() asm volatile("s_waitcnt vmcnt(0)" ::: "memory")
#define XB_TMO      128
#define XB_XCNT(j)  (256  + 64 * (j))
#define XB_XSUB(j)  (1280 + 64 * (j))
#define XB_XGEN(j)  (2304 + 64 * (j))
#define XB_TOP      3328
#define XB_TOPGEN   3392
#define XCD_BAR_WORDS 3456
#define XB_SPIN_CAP (1u << 18)

__device__ __forceinline__ unsigned xb_ld(unsigned* p)              { return __hip_atomic_load(p, __ATOMIC_RELAXED, __HIP_MEMORY_SCOPE_AGENT); }
__device__ __forceinline__ unsigned xb_add(unsigned* p, unsigned v) { return __hip_atomic_fetch_add(p, v, __ATOMIC_RELAXED, __HIP_MEMORY_SCOPE_AGENT); }
__device__ __forceinline__ unsigned xb_xcc_id() { return (unsigned)__builtin_amdgcn_s_getreg((3 << 11) | 20) & 0xFu; }
#define XB_SPIN(cond, bar) do { unsigned _sp = 0; while (cond) { __builtin_amdgcn_s_sleep(1); \
    if ((++_sp & 255u) == 0u) { if (xb_ld(&(bar)[XB_TMO])) break; if (_sp > XB_SPIN_CAP) { atomicAdd(&(bar)[XB_TMO], 1u); break; } } } } while (0)

struct XcdBarrier {
    unsigned* bar; unsigned x;
    volatile LAS unsigned* st;
};

__device__ __forceinline__ XcdBarrier xcd_barrier_post(unsigned* bar, volatile LAS unsigned* st) {
    XcdBarrier b; b.bar = bar; b.x = xb_xcc_id(); b.st = st;
    if (threadIdx.x == 0) (void)xb_add(&bar[XB_XCNT(b.x)], 1u);
    return b;
}
__device__ __forceinline__ void xcd_barrier_complete(unsigned* bar, unsigned x, unsigned& nloc, unsigned& nx) {
    const unsigned G = gridDim.x * gridDim.y * gridDim.z;
    unsigned sum, cnt, mine, sp = 0u;
    for (;;) {
        sum = 0u; cnt = 0u; mine = 0u;
#pragma unroll
        for (unsigned j = 0; j < 16; ++j) { const unsigned c = xb_ld(&bar[XB_XCNT(j)]); sum += c; cnt += (c > 0u) ? 1u : 0u; mine = (j == x) ? c : mine; }
        if (sum == G) break;
        __builtin_amdgcn_s_sleep(1);
        if ((++sp & 255u) == 0u) { if (xb_ld(&bar[XB_TMO])) break; if (sp > XB_SPIN_CAP) { atomicAdd(&bar[XB_TMO], 1u); break; } }
    }
    nloc = mine > 0u ? mine : 1u; nx = cnt > 0u ? cnt : 1u;
}

__device__ __forceinline__ void xcd_barrier(const XcdBarrier& b) {
    asm volatile("s_waitcnt vmcnt(0)" ::: "memory");
    __syncthreads();
    if (threadIdx.x == 0) {
        unsigned* bar = b.bar;
        __builtin_amdgcn_s_waitcnt(0);
        unsigned nloc = b.st[0], nx = b.st[1];
        if (nloc == 0u) { xcd_barrier_complete(bar, b.x, nloc, nx); b.st[0] = nloc; b.st[1] = nx; }
        const unsigned old = xb_add(&bar[XB_XSUB(b.x)], 1u);
        const unsigned gen = old / nloc;
        if (old + 1u == (gen + 1u) * nloc) {
            __builtin_amdgcn_fence(__ATOMIC_RELEASE, "agent");
            asm volatile("s_waitcnt vmcnt(0)" ::: "memory");
            const unsigned og = xb_add(&bar[XB_TOP], 1u);
            const unsigned tg = og / nx;
            if (og + 1u == (tg + 1u) * nx) xb_add(&bar[XB_TOPGEN], 1u);
            else XB_SPIN(xb_ld(&bar[XB_TOPGEN]) == tg, bar);
            __builtin_amdgcn_fence(__ATOMIC_ACQUIRE, "agent");
            xb_add(&bar[XB_XGEN(b.x)], 1u);
            asm volatile("s_waitcnt vmcnt(0)" ::: "memory");
        } else {
            XB_SPIN(xb_ld(&bar[XB_XGEN(b.x)]) == gen, bar);
            __builtin_amdgcn_fence(__ATOMIC_ACQUIRE, "agent");
            asm volatile("s_waitcnt vmcnt(0)" ::: "memory");
        }
    }
    __syncthreads();
}

constexpr int SEQ = 8192, DM = 4096, HD = 128, DFF = 16384, PLE = 256;
constexpr int NIN = 25632, NPROJ = 25856;
constexpr int PROJ_LD = 16640;
constexpr int C_QKVB = 0, C_BA = 6144, C_ZB = 6400, C_GA = 8448, C_GB = 12544, C_QA = 16640, C_KA = 19712, C_VA = 22784;
constexpr int NPA = 8192, NPB1 = 12288, NPB2 = NPROJ - NPA - NPB1;
static_assert(SEQ == (1 << pg8::EP_LSEQ) && C_QA == 256 * pg8::EP_ATT_TILE0 && C_QA == PROJ_LD && C_KA == C_QA + 3072 && C_VA == C_KA + 3072 && NPROJ == C_VA + 3072, "attention tile map");
static_assert(NPB2 == 5376, "parts");
constexpr int DNH = 16, DNW = 2048, ATW = 1024;
constexpr float EPS = 1e-6f;
constexpr int NWAVES = 8;
constexpr int PADK = 0;
#define LDP(K_) ((K_) + PADK)
constexpr int NCH = SEQ / 64;
constexpr int DN_LDS_PER_WAVE = 17920, ABLK_BYTES = 57344;
typedef short v4i16_t __attribute__((ext_vector_type(4)));
#define DN_SWZ(row) ((((row) & 7) ^ ((((row) >> 3) & 1) << 2)))

constexpr size_t MiB = 1u << 20;
constexpr size_t WS_CTL = 0, CTL_ZERO_BYTES = 1 * MiB;
constexpr size_t WS_WIN = 2 * MiB, WS_WAU = 208 * MiB, WS_WDU = 217 * MiB, WS_WOUT = 234 * MiB, WS_WUP = 267 * MiB, WS_WDN = 397 * MiB, WS_WG = 526 * MiB, WS_WPP = 559 * MiB;
constexpr size_t WS_H = 562 * MiB, WS_PB = 627 * MiB, WS_BA = 632 * MiB, WS_BETA = 633 * MiB, WS_GC = 633 * MiB + 512 * 1024, WS_EGL = 634 * MiB;
constexpr size_t WS_PROJ = 636 * MiB, WS_HID = 636 * MiB, WS_PP = 894 * MiB, WS_AQ = 896 * MiB;
constexpr size_t WS_OA = 1040 * MiB, WS_OB = 1057 * MiB, WS_OG = 1090 * MiB, WS_LSE = 1186 * MiB;
constexpr size_t WS_KF = 1187 * MiB, WS_QF = 1219 * MiB, WS_VBT = 1251 * MiB, WS_KBGT = 1283 * MiB, WS_ABLK = 1315 * MiB, WS_U = 1427 * MiB, WS_O = 1491 * MiB;
constexpr size_t WS_T1 = 1187 * MiB, WS_MERGED = 1315 * MiB, WS_X1 = 1380 * MiB;
constexpr size_t WS_SSQ1 = 1556 * MiB, WS_SSQ2 = 1558 * MiB, WS_SSQP = 1560 * MiB, WS_RSTD = 1562 * MiB;
constexpr size_t WS_END = 1563 * MiB;
constexpr int CW_BAR = 4096;

constexpr int RING_OFF = 0, RING_BYTES = 131072;
constexpr int LDSCTL_OFF = 143360, MISC_OFF = LDSCTL_OFF + 320;
constexpr int LDS_BYTES = 147456;

__device__ __forceinline__ unsigned f2bf(float f) { unsigned u = __builtin_bit_cast(unsigned, f); return (u + 0x7fffu + ((u >> 16) & 1u)) >> 16; }
__device__ __forceinline__ unsigned pk2(float lo, float hi) { return f2bf(lo) | (f2bf(hi) << 16); }
__device__ __forceinline__ float bf2f(unsigned short b) { return __uint_as_float(((unsigned)b) << 16); }
__device__ __forceinline__ float wave_sum(float v) {
#pragma unroll
    for (int o = 1; o < 64; o <<= 1) v += __shfl_xor(v, o);
    return v;
}
__device__ __forceinline__ int static_pm0(int M, int N, int c) {
    const int nM = M / pg8::BM, nN = N / pg8::BM, nwg = nM * nN, q = nwg / pg8::NXCD, r = nwg % pg8::NXCD, xcd = c % pg8::NXCD, off = c / pg8::NXCD;
    const int wgid = (xcd < r ? xcd * (q + 1) : r * (q + 1) + (xcd - r) * q) + off, nig = pg8::WGM * nN, fm = (wgid / nig) * pg8::WGM, gsz = (nM - fm) < pg8::WGM ? (nM - fm) : pg8::WGM;
    return fm + ((wgid % nig) % gsz);
}
__device__ __forceinline__ void panel_rstd(const float* __restrict__ ssq, float* __restrict__ rstd, int pm, int tid) {
    const int row = pm * 256 + (tid >> 1); const f32x4* p = (const f32x4*)(ssq + (size_t)row * 64 + (tid & 1) * 32);
    f32x4 a = p[0];
#pragma unroll
    for (int j = 1; j < 8; ++j) a += p[j];
    float s = (a[0] + a[1]) + (a[2] + a[3]); s += __shfl_xor(s, 1);
    if (!(tid & 1)) rstd[row] = 1.0f / sqrtf(s * (1.f / DM) + EPS);
}
__device__ __forceinline__ float wave_max(float v) {
#pragma unroll
    for (int o = 1; o < 64; o <<= 1) v = fmaxf(v, __shfl_xor(v, o));
    return v;
}

__device__ __forceinline__ void tile_load(f32x4 (&v)[8], const float* W, int N, int k0, int n0, int lane) {
    const int kr = lane >> 3, nc = (lane & 7) * 4;
#pragma unroll
    for (int i = 0; i < 8; ++i) v[i] = __builtin_nontemporal_load((const GAS f32x4*)(W + (size_t)(k0 + 8 * i + kr) * N + n0 + nc));
}
__device__ __forceinline__ void tile_store(const f32x4 (&v)[8], bf16* WT, int K, int k0, int drow0, LAS float* scr, int lane, int kdoff) {
    const int kr = lane >> 3, nc = (lane & 7) * 4;
#pragma unroll
    for (int i = 0; i < 8; ++i) { LAS float* d = scr + (8 * i + kr) * 33 + nc; d[0] = v[i].x; d[1] = v[i].y; d[2] = v[i].z; d[3] = v[i].w; }
    LDS_WAIT(); asm volatile("" ::: "memory");
    const int c = lane & 7;
#pragma unroll
    for (int j = 0; j < 4; ++j) { const int n = (lane >> 3) + 8 * j; const LAS float* s = scr + (8 * c) * 33 + n;
        v4u o; o.x = pk2(s[0 * 33], s[1 * 33]); o.y = pk2(s[2 * 33], s[3 * 33]); o.z = pk2(s[4 * 33], s[5 * 33]); o.w = pk2(s[6 * 33], s[7 * 33]);
        __builtin_nontemporal_store(o, (GAS v4u*)(WT + kt_off((size_t)(drow0 + n), kdoff + k0 + 8 * c, K))); }
    LDS_WAIT(); asm volatile("" ::: "memory");
}
__device__ __forceinline__ void tile_gain(f32x4 (&v)[8], const float* gk, int k0, int lane) {
#pragma unroll
    for (int i = 0; i < 8; ++i) v[i] = v[i] * gk[k0 + 8 * i + (lane >> 3)];
}
__device__ __forceinline__ void transpose_tile(const float* W, int N, bf16* WT, int K, int k0, int n0, int drow0, LAS float* scr, int lane, int kdoff = 0, const float* gk = nullptr) {
    f32x4 v[8]; tile_load(v, W, N, k0, n0, lane); if (gk) tile_gain(v, gk, k0, lane); tile_store(v, WT, K, k0, drow0, scr, lane, kdoff);
}
__device__ __forceinline__ int win_d0(int n0) { return n0 < 9216 ? C_QA + n0 : (n0 < 15360 ? C_QKVB + n0 - 9216 : (n0 < 17408 ? C_ZB + n0 - 15360 : (n0 < 17440 ? C_BA + n0 - 17408 : (n0 < 21536 ? C_GA + n0 - 17440 : C_GB + n0 - 21536)))); }
__device__ __forceinline__ int win_cls(int it) { const int d0 = win_d0(32 * (it % (NIN / 32))); return d0 < NPA ? 1 : (d0 < NPA + NPB1 ? 2 : 3); }
__device__ __forceinline__ void norm_row_bf16(const float* xrow, const float* g, bf16* obase, int orow, int lane) {
    const GAS f32x4* xr = (const GAS f32x4*)xrow + lane; const GAS f32x4* gr = (const GAS f32x4*)g + lane;
    f32x4 v[16]; float s = 0.f;
#pragma unroll
    for (int j = 0; j < 16; ++j) { v[j] = xr[64 * j]; s += (v[j].x * v[j].x + v[j].y * v[j].y) + (v[j].z * v[j].z + v[j].w * v[j].w); }
    const float rstd = 1.0f / sqrtf(wave_sum(s) * (1.f / DM) + EPS);
#pragma unroll
    for (int j = 0; j < 16; ++j) { const f32x4 gg = gr[64 * j]; const f32x4 y = v[j] * rstd * gg;
        *(GAS unsigned long long*)(obase + kt_off((size_t)orow, 256 * j + 4 * lane, DM)) = (unsigned long long)pk2(y.x, y.y) | ((unsigned long long)pk2(y.z, y.w) << 32); }
}
__device__ __forceinline__ void norm_row_b2f(const bf16* xrow, const float* g, float* orow, int lane) {
    const GAS v4u* xr = (const GAS v4u*)xrow + lane; const GAS f32x4* gr = (const GAS f32x4*)g + 2 * lane;
    f32x4 v[8][2]; float s = 0.f;
#pragma unroll
    for (int j = 0; j < 8; ++j) { pg8::unpack8(xr[64 * j], v[j][0], v[j][1]); s += pg8::dot4(v[j][0]) + pg8::dot4(v[j][1]); }
    const float rstd = 1.0f / sqrtf(wave_sum(s) * (1.f / DM) + EPS);
    GAS f32x4* o = (GAS f32x4*)orow + 2 * lane;
#pragma unroll
    for (int j = 0; j < 8; ++j) { o[128 * j] = v[j][0] * rstd * gr[128 * j]; o[128 * j + 1] = v[j][1] * rstd * gr[128 * j + 1]; }
}
__device__ __forceinline__ void norm_row_f32(const float* xrow, const float* g, float* orow, int lane) {
    const GAS f32x4* xr = (const GAS f32x4*)xrow + lane; const GAS f32x4* gr = (const GAS f32x4*)g + lane;
    f32x4 v[16]; float s = 0.f;
#pragma unroll
    for (int j = 0; j < 16; ++j) { v[j] = xr[64 * j]; s += (v[j].x * v[j].x + v[j].y * v[j].y) + (v[j].z * v[j].z + v[j].w * v[j].w); }
    const float rstd = 1.0f / sqrtf(wave_sum(s) * (1.f / DM) + EPS);
    GAS f32x4* o = (GAS f32x4*)orow + lane;
#pragma unroll
    for (int j = 0; j < 16; ++j) { const f32x4 gg = gr[64 * j]; o[64 * j] = v[j] * rstd * gg; }
}


#ifndef CV_P3_TILES
#define CV_P3_TILES 0
#endif
constexpr int CV_IN = (DM / 64) * (NIN / 32), CV_AU = (ATW / 64) * (DM / 32), CV_DU = (DNW / 64) * (DM / 32), CV_OUT = (DM / 64) * (DM / 32), CV_UP = (DM / 64) * (DFF / 32), CV_DN = (DFF / 64) * (DM / 32),
              CV_G = CV_OUT, CV_PP = (PLE / 64) * (DM / 32), CV_ALL = CV_IN + CV_AU + CV_DU + CV_OUT + CV_UP + CV_DN + CV_G + CV_PP;
constexpr int CV_TAIL = CV_IN + 28000, CV_P3 = CV_ALL - CV_P3_TILES;
#define CONV_ITEMS(FIRST, LAST, WIDX, NW) CONV_ITEMS_C(FIRST, LAST, WIDX, NW, 0)
#define CONV_ITEMS_C(FIRST, LAST, WIDX, NW, CLS) do { LAS float* scr_ = (LAS float*)(L + RING_OFF + wave * 16384); \
    for (int it_ = (FIRST) + (WIDX); it_ < (LAST); it_ += (NW)) { int r = it_; const int nb4 = DM / 32; \
        if (r < CV_IN) { const int nblk = NIN / 32, kb = r / nblk, nb = r % nblk, n0 = 32 * nb; const int d0 = n0 < 9216 ? C_QA + n0 : (n0 < 15360 ? C_QKVB + n0 - 9216 : (n0 < 17408 ? C_ZB + n0 - 15360 : (n0 < 17440 ? C_BA + n0 - 17408 : (n0 < 21536 ? C_GA + n0 - 17440 : C_GB + n0 - 21536)))); \
            const int cls_ = d0 < NPA ? 1 : (d0 < NPA + NPB1 ? 2 : 3);     \
            if ((CLS) == 0 || (CLS) == cls_) transpose_tile(w_in, NIN, WIN_T, LDP(DM), 64 * kb, n0, d0, scr_, lane); } \
        else if ((r -= CV_IN) < CV_AU) transpose_tile(w_attn_up, DM, WAU_T, LDP(ATW + DNW), 64 * (r / nb4), 32 * (r % nb4), 32 * (r % nb4), scr_, lane, DNW); \
        else if ((r -= CV_AU) < CV_DU) transpose_tile(w_dn_up, DM, WAU_T, LDP(ATW + DNW), 64 * (r / nb4), 32 * (r % nb4), 32 * (r % nb4), scr_, lane); \
        else if ((r -= CV_DU) < CV_OUT) transpose_tile(w_out, DM, WOUT_T, LDP(DM), 64 * (r / nb4), 32 * (r % nb4), 32 * (r % nb4), scr_, lane); \
        else if ((r -= CV_OUT) < CV_UP) { const int nblk = DFF / 32; transpose_tile(w_mlp_up, DFF, WUP_T, LDP(DM), 64 * (r / nblk), 32 * (r % nblk), 32 * (r % nblk), scr_, lane, 0, norm_mlp); } \
        else if ((r -= CV_UP) < CV_DN) transpose_tile(w_mlp_down, DM, WDN_T, LDP(DFF), 64 * (r / nb4), 32 * (r % nb4), 32 * (r % nb4), scr_, lane); \
        else if ((r -= CV_DN) < CV_G) transpose_tile(w_ple_gate, DM, WG_T, LDP(DM), 64 * (r / nb4), 32 * (r % nb4), 32 * (r % nb4), scr_, lane, 0, norm_ple); \
        else { r -= CV_G; transpose_tile(w_ple_proj, DM, WPP_T, LDP(PLE), 64 * (r / nb4), 32 * (r % nb4), 32 * (r % nb4), scr_, lane); } } } while (0)

#define CONV_WIN_PIPE(CLS, WIDX, NW, SCR) do { LAS float* scr_ = (LAS float*)(SCR); const int nblk_ = NIN / 32; \
    int it_ = (WIDX); while (it_ < CV_IN && win_cls(it_) != (CLS)) it_ += (NW); \
    if (it_ < CV_IN) { f32x4 va_[8]; tile_load(va_, w_in, NIN, 64 * (it_ / nblk_), 32 * (it_ % nblk_), lane); \
        for (;;) { int nx_ = it_ + (NW); while (nx_ < CV_IN && win_cls(nx_) != (CLS)) nx_ += (NW); const bool more_ = nx_ < CV_IN; f32x4 vb_[8]; \
            if (more_) tile_load(vb_, w_in, NIN, 64 * (nx_ / nblk_), 32 * (nx_ % nblk_), lane); \
            tile_store(va_, WIN_T, LDP(DM), 64 * (it_ / nblk_), win_d0(32 * (it_ % nblk_)), scr_, lane, 0); \
            if (!more_) break; \
            _Pragma("unroll") for (int i_ = 0; i_ < 8; ++i_) va_[i_] = vb_[i_]; it_ = nx_; } } } while (0)

struct CvT { const float* W; bf16* WT; const float* gk; int N, K, k0, n0, d0, kd; };
#define CV_DESC(R_, T_) do { int r = (R_); const int nb4 = DM / 32; T_.gk = nullptr; \
        if (r < CV_IN) { const int nblk = NIN / 32; T_.W = w_in; T_.N = NIN; T_.WT = WIN_T; T_.K = DM; T_.k0 = 64 * (r / nblk); T_.n0 = 32 * (r % nblk); T_.d0 = win_d0(T_.n0); T_.kd = 0; } \
        else if ((r -= CV_IN) < CV_AU) { T_.W = w_attn_up; T_.N = DM; T_.WT = WAU_T; T_.K = ATW + DNW; T_.k0 = 64 * (r / nb4); T_.n0 = 32 * (r % nb4); T_.d0 = T_.n0; T_.kd = DNW; } \
        else if ((r -= CV_AU) < CV_DU) { T_.W = w_dn_up; T_.N = DM; T_.WT = WAU_T; T_.K = ATW + DNW; T_.k0 = 64 * (r / nb4); T_.n0 = 32 * (r % nb4); T_.d0 = T_.n0; T_.kd = 0; } \
        else if ((r -= CV_DU) < CV_OUT) { T_.W = w_out; T_.N = DM; T_.WT = WOUT_T; T_.K = DM; T_.k0 = 64 * (r / nb4); T_.n0 = 32 * (r % nb4); T_.d0 = T_.n0; T_.kd = 0; } \
        else if ((r -= CV_OUT) < CV_UP) { const int nblk = DFF / 32; T_.W = w_mlp_up; T_.gk = norm_mlp; T_.N = DFF; T_.WT = WUP_T; T_.K = DM; T_.k0 = 64 * (r / nblk); T_.n0 = 32 * (r % nblk); T_.d0 = T_.n0; T_.kd = 0; } \
        else if ((r -= CV_UP) < CV_DN) { T_.W = w_mlp_down; T_.N = DM; T_.WT = WDN_T; T_.K = DFF; T_.k0 = 64 * (r / nb4); T_.n0 = 32 * (r % nb4); T_.d0 = T_.n0; T_.kd = 0; } \
        else if ((r -= CV_DN) < CV_G) { T_.W = w_ple_gate; T_.gk = norm_ple; T_.N = DM; T_.WT = WG_T; T_.K = DM; T_.k0 = 64 * (r / nb4); T_.n0 = 32 * (r % nb4); T_.d0 = T_.n0; T_.kd = 0; } \
        else { r -= CV_G; T_.W = w_ple_proj; T_.N = DM; T_.WT = WPP_T; T_.K = PLE; T_.k0 = 64 * (r / nb4); T_.n0 = 32 * (r % nb4); T_.d0 = T_.n0; T_.kd = 0; } } while (0)
#define CONV_ITEMS_PIPE(FIRST, LAST, WIDX, NW) do { LAS float* scr_ = (LAS float*)(L + RING_OFF + wave * 16384); int it_ = (FIRST) + (WIDX); \
    if (it_ < (LAST)) { CvT ta_; CV_DESC(it_, ta_); f32x4 va_[8]; tile_load(va_, ta_.W, ta_.N, ta_.k0, ta_.n0, lane); \
        for (;;) { const int nx_ = it_ + (NW); const bool more_ = nx_ < (LAST); CvT tb_ = ta_; f32x4 vb_[8]; \
            if (more_) { CV_DESC(nx_, tb_); tile_load(vb_, tb_.W, tb_.N, tb_.k0, tb_.n0, lane); } \
            if (ta_.gk) tile_gain(va_, ta_.gk, ta_.k0, lane); tile_store(va_, ta_.WT, ta_.K, ta_.k0, ta_.d0, scr_, lane, ta_.kd); \
            if (!more_) break; \
            _Pragma("unroll") for (int i_ = 0; i_ < 8; ++i_) va_[i_] = vb_[i_]; ta_ = tb_; it_ = nx_; } } } while (0)

constexpr int ATT_ITEMS = 768;
constexpr int SC_PF = 5;
constexpr int SC_SPLIT = 4, SC_NT = 8 / SC_SPLIT, SCAN_WGS = DNH * SC_SPLIT;
__device__ __forceinline__ void att_ref(swa::BlockRef<swa::bf16, swa::bf16>& b, int& d, int item, const bf16* AQ, bf16* OG, float* LSEB) {
    const int g = item >> 8, rem = item & 255, h = rem & 7, x = rem >> 3;
    d = g == 0 ? 1 : (g == 1 ? 4 : 16); const int nqb = 32 / d, r = x / nqb, qb = x % nqb; const size_t t0 = (size_t)r + (size_t)d * qb * 256;
    const size_t Ls = (size_t)(SEQ / d), hs = (size_t)SEQ * HD;
    b.Q = AQ + (size_t)((0 * 3 + g) * 8 + h) * hs + ((size_t)r * Ls + (size_t)qb * 256) * HD; b.K = AQ + (size_t)((1 * 3 + g) * 8 + h) * hs + (size_t)r * Ls * HD; b.V = AQ + (size_t)((2 * 3 + g) * 8 + h) * hs + (size_t)r * Ls * HD;
    b.O = OG + (size_t)g * SEQ * ATW + t0 * ATW + h * HD; b.LSE = LSEB + (size_t)g * SEQ * 8 + t0 * 8 + h;
    b.P0 = qb * 256; b.rs = HD; b.ors = d * ATW; b.lrs = d * 8;
}

struct Args { const float* in[19]; float* out; unsigned char* ws; int ph_lo, ph_hi, li, pad; };
constexpr int N_PHASES = 17;

__global__ void __launch_bounds__(NWAVES * 64, 2) mk_fwd(Args args) {
    extern __shared__ __attribute__((aligned(16))) unsigned char lds[];
    LAS unsigned char* L = (LAS unsigned char*)lds;
    volatile LAS unsigned* MISC = (volatile LAS unsigned*)(L + MISC_OFF);
    int tid = otid(), lane = tid & 63; const int wave = __builtin_amdgcn_readfirstlane(tid >> 6);
    const int G = gridDim.x; const int bx = blockIdx.x; const int vcu = (G % 8 == 0) ? (bx % 8) * (G / 8) + bx / 8 : bx;
    const int gw = vcu * NWAVES + wave, NGW = G * NWAVES;
    unsigned char* ws = args.ws;
    gu32* ctl = (gu32*)(ws + WS_CTL);
    const float* x = args.in[0]; const float* p_in = args.in[1]; const float* w_in = args.in[2]; const float* conv_w = args.in[3]; const float* dn_a_log = args.in[4]; const float* dn_dt_bias = args.in[5];
    const float* dn_norm = args.in[6]; const float* w_attn_up = args.in[7]; const float* w_dn_up = args.in[8]; const float* w_out = args.in[9]; const float* w_mlp_up = args.in[10]; const float* w_mlp_down = args.in[11];
    const float* w_ple_gate = args.in[12]; const float* w_ple_proj = args.in[13]; const float* norm_mix = args.in[14]; const float* norm_mlp = args.in[15]; const float* norm_ple = args.in[16];
    const float* ple_post_norm = args.in[17]; const float* final_norm = args.in[18];
    float* out = args.out;
    bf16* WIN_T = (bf16*)(ws + WS_WIN); bf16* WAU_T = (bf16*)(ws + WS_WAU); bf16* WDU_T = (bf16*)(ws + WS_WDU); bf16* WOUT_T = (bf16*)(ws + WS_WOUT); bf16* WUP_T = (bf16*)(ws + WS_WUP);
    bf16* WDN_T = (bf16*)(ws + WS_WDN); bf16* WG_T = (bf16*)(ws + WS_WG); bf16* WPP_T = (bf16*)(ws + WS_WPP);
    bf16* HB = (bf16*)(ws + WS_H); bf16* PB = (bf16*)(ws + WS_PB); float* BA = (float*)(ws + WS_BA); float* BETA = (float*)(ws + WS_BETA); float* GC = (float*)(ws + WS_GC); float* EGL = (float*)(ws + WS_EGL);
    bf16* PROJ = (bf16*)(ws + WS_PROJ); bf16* HID = (bf16*)(ws + WS_HID); bf16* PP = (bf16*)(ws + WS_PP); bf16* AQ = (bf16*)(ws + WS_AQ);
    bf16* OA = (bf16*)(ws + WS_OA); bf16* OB = (bf16*)(ws + WS_OB); bf16* OG = (bf16*)(ws + WS_OG); float* LSEB = (float*)(ws + WS_LSE);
    bf16* KF = (bf16*)(ws + WS_KF); bf16* QF = (bf16*)(ws + WS_QF); bf16* VBT = (bf16*)(ws + WS_VBT); bf16* KBGT = (bf16*)(ws + WS_KBGT); unsigned char* ABLK = ws + WS_ABLK; float* U = (float*)(ws + WS_U); float* OS = (float*)(ws + WS_O);
    float* SSQ1 = (float*)(ws + WS_SSQ1); float* SSQ2 = (float*)(ws + WS_SSQ2); float* SSQP = (float*)(ws + WS_SSQP); float* RSTD1 = (float*)(ws + WS_RSTD); float* RSTD2 = RSTD1 + SEQ; float* RSTDP = RSTD2 + SEQ;
    float* T1 = (float*)(ws + WS_T1); bf16* MERGED = (bf16*)(ws + WS_MERGED); bf16* X1 = (bf16*)(ws + WS_X1); bf16* X2 = (bf16*)(ws + WS_X1 + 64 * MiB);

    for (int u = tid; u < (LDS_BYTES - LDSCTL_OFF) / 4; u += NWAVES * 64) ((LAS unsigned*)(L + LDSCTL_OFF))[u] = 0u;
    __syncthreads();
    XcdBarrier bar = xcd_barrier_post((unsigned*)(ctl + CW_BAR) + args.li * XCD_BAR_WORDS, MISC + 8);
    const int lo = args.ph_lo, hi = args.ph_hi;
#ifndef GEMM_ALIGN
#define GEMM_ALIGN true
#endif
#ifndef GEMM_SP2
#define GEMM_SP2 true
#endif
#ifndef DN_PROBE
#define DN_PROBE 0
#endif
#ifndef SCAN_PROBE_VARIANT
#define SCAN_PROBE_VARIANT 0
#endif
#ifndef REPMASK
#define REPMASK 0u
#endif
#ifndef REPN
#define REPN 1
#endif
#ifndef PHMASK
#define PHMASK 0xffffffffu
#endif
#define IN(k) (((PHMASK >> (k)) & 1u) && lo <= (k) && (k) < hi)
#define SEAM(k) do { if (IN(k) && IN((k) + 1)) xcd_barrier(bar); } while (0)

    _Pragma("unroll") for (int _rep = 0; _rep < 1 + REPN * (int)((REPMASK >> 0) & 1u); ++_rep) { if (_rep) xcd_barrier(bar); tid = otid(); lane = tid & 63;
    if (IN(0)) {
        CONV_WIN_PIPE(1, gw, NGW, L + RING_OFF + wave * 16384);
        { const size_t nz = (size_t)(NPROJ - NIN) * (DM / 8);
          for (size_t i = (size_t)gw * 64 + lane; i < nz; i += (size_t)NGW * 64) *(GAS v4u*)(WIN_T + kt_off((size_t)(C_BA + 32) + i / (DM / 8), (int)(i % (DM / 8)) * 8, DM)) = (v4u){0u, 0u, 0u, 0u}; }
#ifdef DBG_NANFILL
        { GAS v4u* z = (GAS v4u*)(ws + WS_KF); const size_t nz = (size_t)(WS_END - WS_KF) / 16;
          for (size_t i = (size_t)gw * 64 + lane; i < nz; i += (size_t)NGW * 64) z[i] = (v4u){0xffffffffu, 0xffffffffu, 0xffffffffu, 0xffffffffu}; }
#endif
        for (int m = gw; m < SEQ; m += NGW) norm_row_bf16(x + (size_t)m * DM, norm_mix, HB, m, lane);
        { const size_t n8 = (size_t)SEQ * PLE / 8;
          for (size_t i = (size_t)gw * 64 + lane; i < n8; i += (size_t)NGW * 64) { const GAS f32x4* s = (const GAS f32x4*)p_in + 2 * i; const f32x4 a = s[0], b = s[1];
              v4u o; o.x = pk2(a.x, a.y); o.y = pk2(a.z, a.w); o.z = pk2(b.x, b.y); o.w = pk2(b.z, b.w); *(GAS v4u*)(PB + kt_off(i / (PLE / 8), (int)(i % (PLE / 8)) * 8, PLE)) = o; } }
    }
    }
    SEAM(0);

    _Pragma("unroll") for (int _rep = 0; _rep < 1 + REPN * (int)((REPMASK >> 1) & 1u); ++_rep) { if (_rep) xcd_barrier(bar); tid = otid(); lane = tid & 63;
    if (IN(1)) {
        pg8::Gemm g{HB, WIN_T, SEQ, NPA, DM, LDP(DM)}; pg8::StaticOrder S; S.init(SEQ, NPA, G, (int)blockIdx.x);
        pg8::EpiProj E{PROJ, PROJ_LD, BA, C_BA / 256, AQ, 0};
        pg8::gemm_phase<pg8::EpiProj, pg8::StaticOrder, GEMM_ALIGN, GEMM_SP2>(L + RING_OFF, g, S, E);
    }
    }
    SEAM(1);

    _Pragma("unroll") for (int _rep = 0; _rep < 1 + REPN * (int)((REPMASK >> 2) & 1u); ++_rep) { if (_rep) xcd_barrier(bar); tid = otid(); lane = tid & 63;
    if (IN(2)) {
        LAS unsigned char* wl = L + wave * DN_LDS_PER_WAVE;
        LAS float* tb = (LAS float*)(wl + 16384);
        const int tq = lane >> 4, cg = lane & 15, fg = lane >> 4, fc = lane & 15;
        for (int it = gw; it < DNH * NCH; it += NGW) {
            const int h = it / NCH, n = it % NCH; const size_t un = (size_t)h * NCH + n;
            { const int t = 64 * n + lane; const float braw = BA[(size_t)t * 32 + h], araw = BA[(size_t)t * 32 + 16 + h];
              const float xs = araw + dn_dt_bias[h]; const float sp = fmaxf(xs, 0.f) + log1pf(expf(-fabsf(xs)));
              const float beta = pg8::sigm(braw); float gc = -expf(dn_a_log[h]) * sp;
#pragma unroll
              for (int o = 1; o < 64; o <<= 1) { const float y = __shfl_up(gc, o); if (lane >= o) gc += y; }
              const float gl = __shfl(gc, 63), eg = expf(gc);
              tb[lane] = eg; tb[64 + lane] = beta * eg; tb[128 + lane] = expf(gl - gc); tb[192 + lane] = beta;
              BETA[(size_t)h * SEQ + t] = beta; GC[(size_t)h * SEQ + t] = gc; if (lane == 0) EGL[un] = expf(gl); }
            LDS_WAIT(); asm volatile("" ::: "memory");
            bf16* KFu = KF + un * 8192; bf16* QFu = QF + un * 8192; bf16* VBTu = VBT + un * 8192; bf16* KBGTu = KBGT + un * 8192; unsigned char* ABu = ABLK + un * ABLK_BYTES;
#pragma unroll 1
            for (int which = 0; which < 3; ++which) {
                const int ch = which * DNW + h * HD + cg * 8;
                f32x4 w[4][2];
#pragma unroll
                for (int j = 0; j < 4; ++j) { w[j][0] = *(const GAS f32x4*)(conv_w + (size_t)j * 3 * DNW + ch); w[j][1] = *(const GAS f32x4*)(conv_w + (size_t)j * 3 * DNW + ch + 4); }
                const bf16* src = PROJ + C_QKVB + ch;
                v4u xr[19];
#pragma unroll
                for (int j = 0; j < 19; ++j) { const int tt = 64 * n + 16 * tq - 3 + j; xr[j] = (v4u){0u, 0u, 0u, 0u}; if (tt >= 0) xr[j] = *(const GAS v4u*)(src + (size_t)tt * PROJ_LD); }
#pragma unroll
                for (int s = 0; s < 16; ++s) {
                    int tq_o = lane >> 4, cg_o = lane & 15; asm volatile("" : "+v"(tq_o), "+v"(cg_o));
                    const int tq = tq_o, cg = cg_o;
                    const int tl = 16 * tq + s, t = 64 * n + tl;
                    f32x4 y0 = {0.f, 0.f, 0.f, 0.f}, y1 = {0.f, 0.f, 0.f, 0.f};
#pragma unroll
                    for (int j = 0; j < 4; ++j) { f32x4 a, b; pg8::unpack8(xr[s + j], a, b); y0 += a * w[j][0]; y1 += b * w[j][1]; }
                    y0 = y0 * pg8::sigm4(y0); y1 = y1 * pg8::sigm4(y1);
                    if (which < 2) {
                        float ss = (y0.x * y0.x + y0.y * y0.y) + (y0.z * y0.z + y0.w * y0.w) + (y1.x * y1.x + y1.y * y1.y) + (y1.z * y1.z + y1.w * y1.w);
                        ss += __shfl_xor(ss, 1); ss += __shfl_xor(ss, 2); ss += __shfl_xor(ss, 4); ss += __shfl_xor(ss, 8);
                        float r = 1.0f / sqrtf(ss + EPS); if (which == 0) r *= 0.08838834764831845f;
                        y0 = y0 * r; y1 = y1 * r;
                    }
                    *(LAS v4u*)(wl + tl * 256 + ((cg ^ (2 * DN_SWZ(tl))) << 4)) = pg8::pack8(y0, y1);
                }
                LDS_WAIT(); asm volatile("" ::: "memory");
                if (which < 2) {
                    const int sw = 2 * DN_SWZ(fc); bf16* dfr = which == 0 ? QFu : KFu;
#pragma unroll 1
                    for (int rt = 0; rt < 4; ++rt) { const LAS unsigned char* rp = wl + (16 * rt + fc) * 256; const float fq_ = tb[16 * rt + fc];
#pragma unroll
                        for (int s = 0; s < 4; ++s) {
                            *(GAS v4u*)(dfr + ((rt * 4 + s) * 64 + lane) * 8) = *(const LAS v4u*)(rp + (((4 * s + fg) ^ sw) << 4));
                            if (which == 0) {
                                const unsigned long long lo = *(const LAS unsigned long long*)(rp + (((4 * s + (fg >> 1)) ^ sw) << 4) + (fg & 1) * 8), hi = *(const LAS unsigned long long*)(rp + (((4 * s + 2 + (fg >> 1)) ^ sw) << 4) + (fg & 1) * 8);
                                const unsigned l0 = (unsigned)lo, l1 = (unsigned)(lo >> 32), h0 = (unsigned)hi, h1 = (unsigned)(hi >> 32);
                                v4u o; o.x = pg8::cvt_pk_bf16(__uint_as_float(l0 << 16) * fq_, __uint_as_float(l0 & 0xffff0000u) * fq_); o.y = pg8::cvt_pk_bf16(__uint_as_float(l1 << 16) * fq_, __uint_as_float(l1 & 0xffff0000u) * fq_);
                                o.z = pg8::cvt_pk_bf16(__uint_as_float(h0 << 16) * fq_, __uint_as_float(h0 & 0xffff0000u) * fq_); o.w = pg8::cvt_pk_bf16(__uint_as_float(h1 << 16) * fq_, __uint_as_float(h1 & 0xffff0000u) * fq_);
                                *(GAS v4u*)(ABu + (size_t)(16 + rt * 4 + s) * 1024 + lane * 16) = o; }
                        } }
                }
                if (which == 0) { LDS_WAIT(); asm volatile("" ::: "memory"); continue; }
                if (_rep && DN_PROBE == 2) continue;
                LDS_WAIT(); asm volatile("" ::: "memory");
                const int qq = fc >> 2, pp = fc & 3;
#define DN_TRREAD(ROW, CT) __builtin_amdgcn_ds_read_tr16_b64_v4i16((LAS v4i16_t*)(wl + (ROW) * 256 + (((2 * (CT) + (pp >> 1)) ^ (2 * DN_SWZ(ROW))) << 4) + (pp & 1) * 8))
#define DN_SCALE4(V, F) pg8::cvt_pk_bf16(bf2f((unsigned short)(V)[0]) * (F)[0], bf2f((unsigned short)(V)[1]) * (F)[1]), pg8::cvt_pk_bf16(bf2f((unsigned short)(V)[2]) * (F)[2], bf2f((unsigned short)(V)[3]) * (F)[3])
#pragma unroll 1
                for (int s2 = 0; s2 < 2; ++s2) {
                    const LAS float* ft = tb + (which == 1 ? 64 : 192) + 32 * s2 + 8 * fg; const f32x4 f0 = *(const LAS f32x4*)ft, f1 = *(const LAS f32x4*)(ft + 4);
                    bf16* dstn = (which == 1 ? KBGTu : VBTu);
#pragma unroll 2
                    for (int ct = 0; ct < 8; ++ct) {
                        const v4i16_t a = DN_TRREAD(32 * s2 + 8 * fg + qq, ct), b = DN_TRREAD(32 * s2 + 8 * fg + 4 + qq, ct);
                        v4u o = {DN_SCALE4(a, f0), DN_SCALE4(b, f1)};
                        *(GAS v4u*)(dstn + ((ct * 2 + s2) * 64 + lane) * 8) = o;
                    }
                    if (which == 1) {
                        const LAS float* fk = tb + 128 + 32 * s2 + 4 * fg; const f32x4 k0 = *(const LAS f32x4*)fk, k1 = *(const LAS f32x4*)(fk + 16);
#pragma unroll 2
                        for (int kt = 0; kt < 8; ++kt) {
                            const v4i16_t a = DN_TRREAD(32 * s2 + 4 * fg + qq, kt), b = DN_TRREAD(32 * s2 + 16 + 4 * fg + qq, kt);
                            v4u o = {DN_SCALE4(a, k0), DN_SCALE4(b, k1)};
                            *(GAS v4u*)(ABu + (size_t)(32 + kt * 2 + s2) * 1024 + lane * 16) = o;
                        }
                    }
                }
                LDS_WAIT(); asm volatile("" ::: "memory");
            }
        }
    }
    }
#ifdef DN_SEAM_BARRIER
    SEAM(2);
#else
    if (IN(2) && IN(3)) { VM_WAIT(); asm volatile("" ::: "memory"); } else SEAM(2);
#endif

    _Pragma("unroll") for (int _rep = 0; _rep < 1 + REPN * (int)((REPMASK >> 3) & 1u); ++_rep) { if (_rep) xcd_barrier(bar); tid = otid(); lane = tid & 63;
    if (IN(3)) {
        LAS unsigned char* wl = L + wave * DN_LDS_PER_WAVE;
        LAS float* Am = (LAS float*)wl;
        LAS float* tbb = (LAS float*)(wl + 17408);
        const int fg = lane >> 4, fc = lane & 15;
        for (int it = gw; it < DNH * NCH; it += NGW) {
            const int h = it / NCH, n = it % NCH; const size_t un = (size_t)h * NCH + n;
            const bf16* KFu = KF + un * 8192; const bf16* QFu = QF + un * 8192; const bf16* VBTu = VBT + un * 8192; const bf16* KBGTu = KBGT + un * 8192; unsigned char* ABu = ABLK + un * ABLK_BYTES;
            { const int t = 64 * n + lane; tbb[lane] = BETA[(size_t)h * SEQ + t]; tbb[64 + lane] = GC[(size_t)h * SEQ + t]; }
            bf16x8 kf[4][4];
#pragma unroll
            for (int rt = 0; rt < 4; ++rt)
#pragma unroll
                for (int s = 0; s < 4; ++s) kf[rt][s] = *(const GAS bf16x8*)(KFu + ((rt * 4 + s) * 64 + lane) * 8);
            LDS_WAIT(); asm volatile("" ::: "memory");
#pragma unroll
            for (int mt = 0; mt < 4; ++mt) {
                const f32x4 bi = *(const LAS f32x4*)(tbb + 16 * mt + 4 * fg), gi = *(const LAS f32x4*)(tbb + 64 + 16 * mt + 4 * fg);
#pragma unroll
                for (int nt = 0; nt <= mt; ++nt) {
                    f32x4 acc = {0.f, 0.f, 0.f, 0.f};
#pragma unroll
                    for (int s = 0; s < 4; ++s) acc = __builtin_amdgcn_mfma_f32_16x16x32_bf16(kf[mt][s], kf[nt][s], acc, 0, 0, 0);
                    const float gj = tbb[64 + 16 * nt + fc]; const int j = 16 * nt + fc;
#pragma unroll
                    for (int r = 0; r < 4; ++r) { const int i = 16 * mt + 4 * fg + r; const float v = bi[r] * acc[r] * __expf(fminf(gi[r] - gj, 0.f)); Am[i * 68 + j] = (i > j) ? v : 0.f; }
                }
            }
#pragma unroll 2
            for (int nt = 0; nt < 4; ++nt) {
                bf16x8 qf[4];
#pragma unroll
                for (int s = 0; s < 4; ++s) qf[s] = *(const GAS bf16x8*)(QFu + ((nt * 4 + s) * 64 + lane) * 8);
                const float gi = tbb[64 + 16 * nt + fc]; const int i = 16 * nt + fc;
#pragma unroll
                for (int s2 = 0; s2 < 2; ++s2) {
                    v4u o;
#pragma unroll
                    for (int hh = 0; hh < 2; ++hh) {
                        const int mt = 2 * s2 + hh; f32x4 acc = {0.f, 0.f, 0.f, 0.f};
#pragma unroll
                        for (int s = 0; s < 4; ++s) acc = __builtin_amdgcn_mfma_f32_16x16x32_bf16(kf[mt][s], qf[s], acc, 0, 0, 0);
                        const f32x4 gj = *(const LAS f32x4*)(tbb + 64 + 16 * mt + 4 * fg); float v[4];
#pragma unroll
                        for (int r = 0; r < 4; ++r) { const int j = 16 * mt + 4 * fg + r; const float e = acc[r] * __expf(fminf(gi - gj[r], 0.f)); v[r] = (i >= j) ? e : 0.f; }
                        if (hh == 0) { o.x = pg8::cvt_pk_bf16(v[0], v[1]); o.y = pg8::cvt_pk_bf16(v[2], v[3]); } else { o.z = pg8::cvt_pk_bf16(v[0], v[1]); o.w = pg8::cvt_pk_bf16(v[2], v[3]); }
                    }
                    *(GAS v4u*)(ABu + (size_t)(48 + nt * 2 + s2) * 1024 + lane * 16) = o;
                }
            }
            LDS_WAIT(); asm volatile("" ::: "memory");
            float Tc[64];
#pragma unroll
            for (int i = 0; i < 64; ++i) {
                float a = (lane == i) ? 1.f : 0.f;
                if (!(_rep && DN_PROBE == 3))
#pragma unroll
                for (int j0 = 0; j0 < i; j0 += 4) { const f32x4 av = *(const LAS f32x4*)(Am + i * 68 + j0);
                    a -= av.x * Tc[j0]; if (j0 + 1 < i) a -= av.y * Tc[j0 + 1]; if (j0 + 2 < i) a -= av.z * Tc[j0 + 2]; if (j0 + 3 < i) a -= av.w * Tc[j0 + 3]; }
                Tc[i] = a;
                if ((i & 7) == 7) asm volatile("" ::: "memory");
            }
            LDS_WAIT(); asm volatile("" ::: "memory");
#pragma unroll
            for (int i = 0; i < 64; ++i) *(LAS unsigned short*)(wl + i * 144 + lane * 2) = (unsigned short)f2bf(Tc[i]);
            LDS_WAIT(); asm volatile("" ::: "memory");
            bf16x8 vbt[8][2], kbt[8][2];
#pragma unroll
            for (int q = 0; q < 8; ++q)
#pragma unroll
                for (int s2 = 0; s2 < 2; ++s2) vbt[q][s2] = *(const GAS bf16x8*)(VBTu + ((q * 2 + s2) * 64 + lane) * 8);
            bf16x8 tf[4][2];
#pragma unroll
            for (int rt = 0; rt < 4; ++rt)
#pragma unroll
                for (int s2 = 0; s2 < 2; ++s2) tf[rt][s2] = *(const LAS bf16x8*)(wl + (16 * rt + fc) * 144 + (32 * s2 + 8 * fg) * 2);
            if (!(_rep && DN_PROBE == 4)) {
            float* Uu = U + un * 8192;
#pragma unroll
            for (int cw = 0; cw < 8; ++cw) {
                const bf16x8 v0 = vbt[cw][0], v1 = vbt[cw][1];
#pragma unroll
                for (int mt = 0; mt < 4; ++mt) { f32x4 acc = {0.f, 0.f, 0.f, 0.f};
                    acc = __builtin_amdgcn_mfma_f32_16x16x32_bf16(tf[mt][0], v0, acc, 0, 0, 0); acc = __builtin_amdgcn_mfma_f32_16x16x32_bf16(tf[mt][1], v1, acc, 0, 0, 0);
                    *(GAS f32x4*)(Uu + ((mt * 8 + cw) * 64 + lane) * 4) = acc; }
            }
            asm volatile("" ::: "memory");
#pragma unroll
            for (int q = 0; q < 8; ++q)
#pragma unroll
                for (int s2 = 0; s2 < 2; ++s2) kbt[q][s2] = *(const GAS bf16x8*)(KBGTu + ((q * 2 + s2) * 64 + lane) * 8);
#pragma unroll
            for (int s = 0; s < 4; ++s) {
                f32x4 acc[4][2];
#pragma unroll
                for (int hh = 0; hh < 2; ++hh) { const int dt = 2 * s + hh;
                    const bf16x8 k0 = kbt[dt][0], k1 = kbt[dt][1];
#pragma unroll
                    for (int nt = 0; nt < 4; ++nt) { f32x4 a = {0.f, 0.f, 0.f, 0.f};
                        a = __builtin_amdgcn_mfma_f32_16x16x32_bf16(k0, tf[nt][0], a, 0, 0, 0); a = __builtin_amdgcn_mfma_f32_16x16x32_bf16(k1, tf[nt][1], a, 0, 0, 0); acc[nt][hh] = a; } }
#pragma unroll
                for (int nt = 0; nt < 4; ++nt) *(GAS v4u*)(ABu + (size_t)(nt * 4 + s) * 1024 + lane * 16) = pg8::pack8(-acc[nt][0], -acc[nt][1]);
            }
            }
            LDS_WAIT(); asm volatile("" ::: "memory");
        }
        if (_rep == 0) CONV_WIN_PIPE(2, gw, NGW, L + wave * DN_LDS_PER_WAVE);
    }
    }
    SEAM(3);

    _Pragma("unroll") for (int _rep = 0; _rep < 1 + REPN * (int)((REPMASK >> 4) & 1u); ++_rep) { if (_rep) xcd_barrier(bar); tid = otid(); lane = tid & 63;
    if (IN(4)) {
        if (bx < SCAN_WGS) { if (!(_rep && SCAN_PROBE_VARIANT == 3)) {
            const int q8 = bx >> 3, h = (bx & 7) * 2 + (q8 & 1), split = q8 >> 1, fg = lane >> 4, fc = lane & 15;
            const bool cwave = wave < SC_NT; const int cw = split * SC_NT + (cwave ? wave : 0);
            const unsigned char* ab = ABLK + (size_t)h * NCH * ABLK_BYTES; const float* Uh = U + (size_t)h * NCH * 8192; const int sv = _rep ? SCAN_PROBE_VARIANT : 0; float* Oh = (_rep ? out : OS) + h * HD + 16 * cw + fc;
            f32x4 S[8]; bf16x8 Sb[4];
#pragma unroll
            for (int kt = 0; kt < 8; ++kt) S[kt] = (f32x4){0.f, 0.f, 0.f, 0.f};
#pragma unroll
            for (int s = 0; s < 4; ++s) Sb[s] = (bf16x8){0, 0, 0, 0, 0, 0, 0, 0};
#define SC_DMA(N_, B_) do { _Pragma("unroll") for (int _i = 0; _i < 7; ++_i) \
        __builtin_amdgcn_global_load_lds((const unsigned*)(ab + (size_t)(N_) * ABLK_BYTES + (wave + 8 * _i) * 1024 + lane * 16), (LAS unsigned*)(L + (B_) * ABLK_BYTES + (wave + 8 * _i) * 1024), 16, 0, 0); } while (0)
#define SC_FRAG(BUF, F_) (*(const LAS bf16x8*)((BUF) + (F_) * 1024 + lane * 16))
#define SC_LD1(F, S_) do { _Pragma("unroll") for (int mt = 0; mt < 4; ++mt) { F[mt] = SC_FRAG(buf, mt * 4 + (S_)); F[4 + mt] = SC_FRAG(buf, 16 + mt * 4 + (S_)); } } while (0)
#define SC_MM1(F, S_) do { _Pragma("unroll") for (int mt = 0; mt < 4; ++mt) { vn[mt] = __builtin_amdgcn_mfma_f32_16x16x32_bf16(F[mt], Sb[S_], vn[mt], 0, 0, 0); \
                                                                             oo[mt] = __builtin_amdgcn_mfma_f32_16x16x32_bf16(F[4 + mt], Sb[S_], oo[mt], 0, 0, 0); } } while (0)
#define SC_SB() __builtin_amdgcn_sched_barrier(0)
            f32x4 ucur[4], unxt[4], oprev[4]; float gcur, gnxt;
#pragma unroll
            for (int mt = 0; mt < 4; ++mt) { ucur[mt] = *(const GAS f32x4*)(Uh + ((mt * 8 + cw) * 64 + lane) * 4); unxt[mt] = ucur[mt]; oprev[mt] = ucur[mt]; }
            gcur = GC[(size_t)h * SEQ + 63]; gnxt = gcur;
            SC_DMA(0, 0);
            VM_WAIT(); __syncthreads();
#pragma unroll 1
            for (int n = 0; n < NCH; ++n) {
                if (n + 1 < NCH) {
                    if (cwave) {
#pragma unroll
                        for (int mt = 0; mt < 4; ++mt) unxt[mt] = *(const GAS f32x4*)(Uh + (size_t)(n + 1) * 8192 + ((mt * 8 + cw) * 64 + lane) * 4);
                        gnxt = GC[(size_t)h * SEQ + 64 * (n + 1) + 63]; }
                    if (sv != 1) SC_DMA(n + 1, (n + 1) & 1); }
                if (cwave && sv != 2) {
                    const float egl = __expf(gcur);
                    const LAS unsigned char* buf = L + (n & 1) * ABLK_BYTES;
                    if (n > 0) {
#pragma unroll
                        for (int mt = 0; mt < 4; ++mt)
#pragma unroll
                            for (int r = 0; r < 4; ++r) Oh[(size_t)(64 * (n - 1) + 16 * mt + 4 * fg + r) * DNW] = oprev[mt][r]; }
                    f32x4 vn[4], oo[4];
#pragma unroll
                    for (int mt = 0; mt < 4; ++mt) { vn[mt] = ucur[mt]; oo[mt] = (f32x4){0.f, 0.f, 0.f, 0.f}; }
                    bf16x8 fa[8], fb[8];
                    SC_LD1(fa, 0); SC_SB();
                    SC_LD1(fb, 1); SC_SB(); SC_MM1(fa, 0); SC_SB();
                    SC_LD1(fa, 2); SC_SB(); SC_MM1(fb, 1); SC_SB();
                    SC_LD1(fb, 3); SC_SB(); SC_MM1(fa, 2); SC_SB();
#pragma unroll
                    for (int q = 0; q < 8; ++q) fa[q] = SC_FRAG(buf, 48 + q);
                    SC_SB(); SC_MM1(fb, 3); SC_SB();
#pragma unroll
                    for (int kt = 0; kt < 8; ++kt) S[kt] = S[kt] * egl;
                    bf16x8 vb2[2];
#pragma unroll
                    for (int s2 = 0; s2 < 2; ++s2) { const v4u w = pg8::pack8(vn[2 * s2], vn[2 * s2 + 1]); vb2[s2] = __builtin_bit_cast(bf16x8, w); }
                    SC_SB();
#pragma unroll
                    for (int q = 0; q < 8; ++q) fb[q] = SC_FRAG(buf, 32 + q);
                    SC_SB();
#pragma unroll
                    for (int s2 = 0; s2 < 2; ++s2)
#pragma unroll
                        for (int kt = 0; kt < 4; ++kt) S[kt] = __builtin_amdgcn_mfma_f32_16x16x32_bf16(fb[kt * 2 + s2], vb2[s2], S[kt], 0, 0, 0);
                    SC_SB();
#pragma unroll
                    for (int q = 0; q < 8; ++q) fb[q] = SC_FRAG(buf, 40 + q);
                    SC_SB();
#pragma unroll
                    for (int s2 = 0; s2 < 2; ++s2)
#pragma unroll
                        for (int mt = 0; mt < 4; ++mt) oo[mt] = __builtin_amdgcn_mfma_f32_16x16x32_bf16(fa[mt * 2 + s2], vb2[s2], oo[mt], 0, 0, 0);
                    SC_SB();
#pragma unroll
                    for (int s2 = 0; s2 < 2; ++s2)
#pragma unroll
                        for (int kt = 0; kt < 4; ++kt) S[4 + kt] = __builtin_amdgcn_mfma_f32_16x16x32_bf16(fb[kt * 2 + s2], vb2[s2], S[4 + kt], 0, 0, 0);
                    SC_SB();
#pragma unroll
                    for (int s = 0; s < 4; ++s) { const v4u w = pg8::pack8(S[2 * s], S[2 * s + 1]); Sb[s] = __builtin_bit_cast(bf16x8, w); }
#pragma unroll
                    for (int mt = 0; mt < 4; ++mt) { oprev[mt] = oo[mt]; ucur[mt] = unxt[mt]; }
                    gcur = gnxt;
                }
                VM_WAIT();
                asm volatile("s_waitcnt lgkmcnt(0)" ::: "memory"); __builtin_amdgcn_s_barrier(); asm volatile("" ::: "memory");
            }
            VM_WAIT();
            if (cwave) {
#pragma unroll
                for (int mt = 0; mt < 4; ++mt)
#pragma unroll
                    for (int r = 0; r < 4; ++r) Oh[(size_t)(64 * (NCH - 1) + 16 * mt + 4 * fg + r) * DNW] = oprev[mt][r]; }
            if (_rep == 0) { CONV_ITEMS_C(0, CV_IN, bx * NWAVES + wave, SCAN_WGS * NWAVES, 3); CONV_ITEMS(CV_TAIL, CV_P3, bx * NWAVES + wave, SCAN_WGS * NWAVES); }
        } } else if (_rep == 0) {
            pg8::Gemm g{HB, WIN_T + (size_t)NPA * LDP(DM), SEQ, NPB1, DM, LDP(DM)}; pg8::StaticOrder S; S.init(SEQ, NPB1, G - SCAN_WGS, bx - SCAN_WGS);
            pg8::EpiProj E{PROJ + NPA, PROJ_LD, BA, -1, AQ, NPA / 256};
            pg8::gemm_phase<pg8::EpiProj, pg8::StaticOrder, GEMM_ALIGN, GEMM_SP2>(L + RING_OFF, g, S, E);
        }
    }
    }
    SEAM(4);

    _Pragma("unroll") for (int _rep = 0; _rep < 1 + REPN * (int)((REPMASK >> 5) & 1u); ++_rep) { if (_rep) xcd_barrier(bar); tid = otid(); lane = tid & 63;
    if (IN(5)) {
        pg8::Gemm g{HB, WIN_T + (size_t)(NPA + NPB1) * LDP(DM), SEQ, NPB2, DM, LDP(DM)}; pg8::StaticOrder S; S.init(SEQ, NPB2, G, (int)blockIdx.x);
        pg8::EpiProj E{PROJ + NPA + NPB1, PROJ_LD, BA, -1, AQ, (NPA + NPB1) / 256};
        pg8::gemm_phase<pg8::EpiProj, pg8::StaticOrder, GEMM_ALIGN, GEMM_SP2>(L + RING_OFF, g, S, E);
        { constexpr int NU = (SEQ / 256) * (NPB2 / 256); const int nfull = NU % G;
          if (nfull && bx >= nfull) CONV_ITEMS(CV_IN, CV_TAIL, (bx - nfull) * NWAVES + wave, (G - nfull) * NWAVES);
          else if (!nfull && bx == 0) CONV_ITEMS(CV_IN, CV_TAIL, wave, NWAVES); }
    }
    }
    SEAM(5);

    _Pragma("unroll") for (int _rep = 0; _rep < 1 + REPN * (int)((REPMASK >> 6) & 1u); ++_rep) { if (_rep) xcd_barrier(bar); tid = otid(); lane = tid & 63;
    if (IN(6)) {
        {
            const int nwg = G; int Lc = bx;
            if (Lc < ATT_ITEMS) {
                typedef swa::BlockRef<swa::bf16, swa::bf16> BR;
                BR cur; int dcur; att_ref(cur, dcur, Lc, AQ, OG, LSEB);
                swa::Seam<swa::bf16> Sm;
                swa::causal_swa_prime<swa::bf16, swa::bf16>(cur, 129, (char*)lds, Sm);
                for (;;) {
                    const int Ln = Lc + nwg; const bool last = Ln >= ATT_ITEMS;
                    BR nxt = cur; int dn = dcur; if (!last) att_ref(nxt, dn, Ln, AQ, OG, LSEB);
                    swa::causal_swa_block<swa::bf16, swa::bf16>(cur, nxt, SEQ / dcur, 129, (char*)lds, Sm);
                    if (last) break;
                    cur = nxt; dcur = dn; Lc = Ln;
                }
            }
        }
    }
    }
    SEAM(6);


    _Pragma("unroll") for (int _rep = 0; _rep < 1 + REPN * (int)((REPMASK >> 7) & 1u); ++_rep) { if (_rep) xcd_barrier(bar); tid = otid(); lane = tid & 63;
    if (IN(7)) {
        for (int t = gw; t < SEQ; t += NGW) {
            {
#pragma unroll
              for (int j = 0; j < 4; ++j) { const int col = 256 * j + 4 * lane, hh = col >> 7;
                  const float l0 = LSEB[(size_t)t * 8 + hh], l1 = LSEB[(size_t)SEQ * 8 + (size_t)t * 8 + hh], l2 = LSEB[(size_t)2 * SEQ * 8 + (size_t)t * 8 + hh];
                  const float mx = fmaxf(l0, fmaxf(l1, l2)); const float e0 = __expf(l0 - mx), e1 = __expf(l1 - mx), e2 = __expf(l2 - mx); const float inv = 1.0f / (e0 + e1 + e2);
                  const unsigned long long w0 = *(const GAS unsigned long long*)(OG + (size_t)t * ATW + col), w1 = *(const GAS unsigned long long*)(OG + (size_t)SEQ * ATW + (size_t)t * ATW + col), w2 = *(const GAS unsigned long long*)(OG + (size_t)2 * SEQ * ATW + (size_t)t * ATW + col);
#define UNP4(w_) (f32x4){__uint_as_float((unsigned)(w_) << 16), __uint_as_float((unsigned)(w_) & 0xffff0000u), __uint_as_float((unsigned)((w_) >> 32) << 16), __uint_as_float((unsigned)((w_) >> 32) & 0xffff0000u)}
                  const f32x4 a0 = UNP4(w0), a1 = UNP4(w1), a2 = UNP4(w2);
#undef UNP4
                  const f32x4 y = (a0 * e0 + a1 * e1 + a2 * e2) * inv;
                  *(GAS unsigned long long*)(OA + kt_off((size_t)t, DNW + col, ATW + DNW)) = (unsigned long long)pk2(y.x, y.y) | ((unsigned long long)pk2(y.z, y.w) << 32); } }
            const GAS f32x4* op = (const GAS f32x4*)(OS + (size_t)t * DNW) + lane;
#pragma unroll
            for (int j = 0; j < 8; ++j) { const f32x4 v = op[64 * j]; float ss = (v.x * v.x + v.y * v.y) + (v.z * v.z + v.w * v.w);
                ss += __shfl_xor(ss, 1); ss += __shfl_xor(ss, 2); ss += __shfl_xor(ss, 4); ss += __shfl_xor(ss, 8); ss += __shfl_xor(ss, 16);
                const float rstd = 1.0f / sqrtf(ss * (1.f / HD) + EPS); const int col = 256 * j + 4 * lane; const f32x4 gn = *(const GAS f32x4*)(dn_norm + (col & 127));
                const unsigned long long zw = *(const GAS unsigned long long*)(PROJ + (size_t)t * PROJ_LD + C_ZB + col);
                const f32x4 z = {__uint_as_float((unsigned)zw << 16), __uint_as_float((unsigned)zw & 0xffff0000u), __uint_as_float((unsigned)(zw >> 32) << 16), __uint_as_float((unsigned)(zw >> 32) & 0xffff0000u)};
                const f32x4 y = v * rstd * gn * (z * pg8::sigm4(z));
                *(GAS unsigned long long*)(OA + kt_off((size_t)t, col, ATW + DNW)) = (unsigned long long)pk2(y.x, y.y) | ((unsigned long long)pk2(y.z, y.w) << 32); }
        }
    }
    }
    SEAM(7);

    _Pragma("unroll") for (int _rep = 0; _rep < 1 + REPN * (int)((REPMASK >> 9) & 1u); ++_rep) { if (_rep) xcd_barrier(bar); tid = otid(); lane = tid & 63;
    if (IN(9)) {
        pg8::Gemm g{OA, WAU_T, SEQ, DM, ATW + DNW, LDP(ATW + DNW)}; pg8::SegOrder S; S.init(SEQ, DM, G, (int)blockIdx.x);
        pg8::EpiMerge E{PROJ + C_GA, PROJ + C_GB, PROJ_LD, MERGED, LDP(DM)};
        pg8::gemm_phase<pg8::EpiMerge, pg8::SegOrder, GEMM_ALIGN, GEMM_SP2>(L + RING_OFF, g, S, E);
    }
    }
    SEAM(9);
    _Pragma("unroll") for (int _rep = 0; _rep < 1 + REPN * (int)((REPMASK >> 10) & 1u); ++_rep) { if (_rep) xcd_barrier(bar); tid = otid(); lane = tid & 63;
    if (IN(10)) {
        { pg8::Gemm g{MERGED, WOUT_T, SEQ, DM, DM, LDP(DM)}; pg8::StaticOrder S; S.init(SEQ, DM, G, (int)blockIdx.x);
          pg8::EpiResidN<true> E{x, X1, DM, SSQ1, nullptr};
          pg8::gemm_phase<pg8::EpiResidN<true>, pg8::StaticOrder, GEMM_ALIGN, GEMM_SP2>(L + RING_OFF, g, S, E); }
        { pg8::Gemm g{PB, WPP_T, SEQ, DM, PLE, LDP(PLE)}; pg8::StaticOrder S; S.init(SEQ, DM, G, (int)blockIdx.x);
          pg8::EpiF32N E{PP, DM, SSQP};
          pg8::gemm_phase<pg8::EpiF32N, pg8::StaticOrder, GEMM_ALIGN, GEMM_SP2>(L + RING_OFF, g, S, E); }
    }
    }
    SEAM(10);
    _Pragma("unroll") for (int _rep = 0; _rep < 1 + REPN * (int)((REPMASK >> 11) & 1u); ++_rep) { if (_rep) xcd_barrier(bar); tid = otid(); lane = tid & 63;
    if (IN(11)) { }
    }
    _Pragma("unroll") for (int _rep = 0; _rep < 1 + REPN * (int)((REPMASK >> 12) & 1u); ++_rep) { if (_rep) xcd_barrier(bar); tid = otid(); lane = tid & 63;
    if (IN(12)) {
        pg8::Gemm g{X1, WUP_T, SEQ, DFF, DM, LDP(DM)}; pg8::StaticOrder S; S.init(SEQ, DFF, G, (int)blockIdx.x);
        pg8::EpiRelu2S E{HID, LDP(DFF)};
        pg8::gemm_phase<pg8::EpiRelu2S, pg8::StaticOrder, GEMM_ALIGN, GEMM_SP2>(L + RING_OFF, g, S, E);
    }
    }
    SEAM(12);
    _Pragma("unroll") for (int _rep = 0; _rep < 1 + REPN * (int)((REPMASK >> 13) & 1u); ++_rep) { if (_rep) xcd_barrier(bar); tid = otid(); lane = tid & 63;
    if (IN(13)) {
        pg8::Gemm g{HID, WDN_T, SEQ, DM, DFF, LDP(DFF)}; pg8::StaticOrder S; S.init(SEQ, DM, G, (int)blockIdx.x);
        { const int pm0 = static_pm0(SEQ, DM, (int)blockIdx.x); panel_rstd(SSQ1, RSTD1, pm0, tid); __syncthreads(); }
        pg8::EpiResidN<false, true> E{X1, X2, DM, SSQ2, RSTD1};
        pg8::gemm_phase<pg8::EpiResidN<false, true>, pg8::StaticOrder, GEMM_ALIGN, GEMM_SP2>(L + RING_OFF, g, S, E);
    }
    }
    SEAM(13);
#ifdef PROBE_CACHED_GEMM
    {
        struct CachedOrder : pg8::StaticOrder { __device__ bool next(int i, pg8::Unit& u) const { const bool r = pg8::StaticOrder::next(i, u); u.pm &= 1; u.pn &= 1; return r; } };
        xcd_barrier(bar);
        pg8::Gemm g{HID, WDN_T, SEQ, DM, DFF, LDP(DFF)}; CachedOrder S; S.init(SEQ, DM, G, (int)blockIdx.x);
        pg8::EpiF32 E{T1, DM};
        pg8::gemm_phase<pg8::EpiF32, CachedOrder, GEMM_ALIGN, GEMM_SP2>(L + RING_OFF, g, S, E);
        xcd_barrier(bar);
    }
#endif
    _Pragma("unroll") for (int _rep = 0; _rep < 1 + REPN * (int)((REPMASK >> 14) & 1u); ++_rep) { if (_rep) xcd_barrier(bar); tid = otid(); lane = tid & 63;
    if (IN(14)) { }
    }
#ifdef PROBE_BARRIERS
    for (int _b = 0; _b < PROBE_BARRIERS; ++_b) xcd_barrier(bar);
#endif
    _Pragma("unroll") for (int _rep = 0; _rep < 1 + REPN * (int)((REPMASK >> 15) & 1u); ++_rep) { if (_rep) xcd_barrier(bar); tid = otid(); lane = tid & 63;
    if (IN(15)) {
        pg8::Gemm g{X2, WG_T, SEQ, DM, DM, LDP(DM)}; pg8::StaticOrder S; S.init(SEQ, DM, G, (int)blockIdx.x);
        { const int pm0 = static_pm0(SEQ, DM, (int)blockIdx.x); panel_rstd(SSQ2, RSTD2, pm0, tid); panel_rstd(SSQP, RSTDP, pm0, tid); __syncthreads(); }
        pg8::EpiPleN E{X2, PP, X1, DM, RSTD2, RSTDP, ple_post_norm};
        pg8::gemm_phase<pg8::EpiPleN, pg8::StaticOrder, GEMM_ALIGN, GEMM_SP2>(L + RING_OFF, g, S, E);
    }
    }
    SEAM(15);
    _Pragma("unroll") for (int _rep = 0; _rep < 1 + REPN * (int)((REPMASK >> 16) & 1u); ++_rep) { if (_rep) xcd_barrier(bar); tid = otid(); lane = tid & 63;
    if (IN(16)) { for (int m = gw; m < SEQ; m += NGW) norm_row_b2f(X1 + (size_t)m * DM, final_norm, out + (size_t)m * DM, lane); }
    }
#undef IN
#undef SEAM
}

#ifndef MK_N_LAUNCHES
#define MK_N_LAUNCHES 1
#endif
extern "C" void kernel_launch(void* const* d_in, const int* in_sizes, int n_in, void* d_out, int out_size, void* d_ws, size_t ws_size, hipStream_t stream) {
    static int grid = 0;
    if (grid == 0) {
        if (n_in != 19 || in_sizes[0] != SEQ * DM || out_size != SEQ * DM || ws_size < WS_END) { fprintf(stderr, "kernel_launch: unexpected shapes: n_in %d in0 %d out %d ws %zu (need %zu)\n", n_in, n_in > 0 ? in_sizes[0] : -1, out_size, ws_size, (size_t)WS_END); grid = -1; return; }
        int dev = 0, cus = 0, per_cu = 0;
        if (hipGetDevice(&dev) != hipSuccess || hipDeviceGetAttribute(&cus, hipDeviceAttributeMultiprocessorCount, dev) != hipSuccess) { grid = -1; return; }
        if (hipFuncSetAttribute((const void*)mk_fwd, hipFuncAttributeMaxDynamicSharedMemorySize, LDS_BYTES) != hipSuccess) { fprintf(stderr, "kernel_launch: hipFuncSetAttribute failed\n"); grid = -1; return; }
        if (hipOccupancyMaxActiveBlocksPerMultiprocessor(&per_cu, (const void*)mk_fwd, NWAVES * 64, LDS_BYTES) != hipSuccess || per_cu < 1) fprintf(stderr, "kernel_launch: occupancy query says %d\n", per_cu);
        (void)hipGetLastError();
        grid = cus;
    }
    if (grid < 0) return;
    if (hipMemsetAsync((char*)d_ws + WS_CTL, 0, CTL_ZERO_BYTES, stream) != hipSuccess) return;
    Args a{};
    for (int i = 0; i < 19; ++i) a.in[i] = (const float*)d_in[i];
    a.out = (float*)d_out; a.ws = (unsigned char*)d_ws;
    for (int li = 0; li < MK_N_LAUNCHES; ++li) {
        a.ph_lo = li * N_PHASES / MK_N_LAUNCHES; a.ph_hi = (li + 1) * N_PHASES / MK_N_LAUNCHES; a.li = li;
        hipLaunchKernelGGL(mk_fwd, dim3(grid), dim3(NWAVES * 64), LDS_BYTES, stream, a);
        const hipError_t le = hipPeekAtLastError();
        if (le != hipSuccess) { fprintf(stderr, "kernel_launch: launch %d failed: %s\n", li, hipGetErrorName(le)); break; }
    }
}
```

```cpp
#include <hip/hip_runtime.h>
#include <cstdio>
#include <cstdint>
__device__ __forceinline__ int otid() { int t = threadIdx.x; asm volatile("" : "+v"(t)); return t; }
__host__ __device__ __forceinline__ size_t kt_off(size_t row, int k, int Ktot) { return ((((row >> 7) * (size_t)(Ktot >> 6) + (size_t)(k >> 6)) << 7) + (row & 127)) * 64 + (size_t)(k & 63); }
namespace pg8 {
#define PG8_LAS __attribute__((address_space(3)))
typedef unsigned short bf16_t;
typedef short bf16x8 __attribute__((ext_vector_type(8)));
typedef float f32x4 __attribute__((ext_vector_type(4)));
typedef unsigned u32x4 __attribute__((ext_vector_type(4)));
constexpr int BM = 256, BK = 64, HALF = 128, HTB = HALF * BK * 2  , STAGE_BYTES = 8 * HTB, NXCD = 8, WGM = 8;

__host__ __device__ __forceinline__ int lds_byte(int r, int c) { const int st = (r >> 4) * 2 + (c >> 5), rr = r & 15, cc = c & 31, ob = rr * 64 + cc * 2; return st * 1024 + (ob ^ (((ob >> 9) & 1) << 5)); }
__host__ __device__ __forceinline__ void stage_rc(int b, int& R, int& C) { const int st = b / 1024, sb = b % 1024, swz = sb ^ (((sb >> 9) & 1) << 5); R = (st >> 1) * 16 + swz / 64; C = (st & 1) * 32 + (swz % 64) / 2; }
__host__ __device__ __forceinline__ int perm32(int rho) { const int n = rho >> 4, i = rho & 15; return 8 * (i >> 2) + 4 * n + (i & 3); }

struct Unit { int pm, pn, seg; };
struct Gemm { const bf16_t* A; const bf16_t* Bt; int M, N, K, ld; };

struct StaticOrder {
    int nM, nN, nwg, G, c;
    __host__ __device__ void init(int M, int N, int G_, int c_) { nM = M / BM; nN = N / BM; nwg = nM * nN; G = G_; c = c_; }
    __host__ __device__ bool next(int i, Unit& u) const {
        const long L = (long)i * G + c; if (L >= nwg) return false;
        int wgid = (int)L; { const int q = nwg / NXCD, r = nwg % NXCD, xcd = wgid % NXCD, off = wgid / NXCD; wgid = (xcd < r ? xcd * (q + 1) : r * (q + 1) + (xcd - r) * q) + off; }
        const int nig = WGM * nN, gid = wgid / nig, fm = gid * WGM, gsz = (nM - fm) < WGM ? (nM - fm) : WGM;
        u.pm = fm + ((wgid % nig) % gsz); u.pn = (wgid % nig) / gsz; return true;
    }
    __device__ __forceinline__ void a_ready(const Unit&) const {}
    __device__ __forceinline__ void done(const Unit&) const {}
};
typedef float f32x2_t __attribute__((ext_vector_type(2))); typedef __bf16 bf16x2_t __attribute__((ext_vector_type(2)));
__device__ __forceinline__ unsigned cvt_pk_bf16(float lo, float hi) { const f32x2_t v = {lo, hi}; const bf16x2_t b = __builtin_convertvector(v, bf16x2_t); return __builtin_bit_cast(unsigned, b); }

typedef unsigned u32x2 __attribute__((ext_vector_type(2)));
__device__ __forceinline__ float sigm(float x) { return __builtin_amdgcn_rcpf(1.0f + __builtin_amdgcn_exp2f(-1.4426950408889634f * x)); }
__device__ __forceinline__ f32x4 sigm4(f32x4 x) { return (f32x4){sigm(x[0]), sigm(x[1]), sigm(x[2]), sigm(x[3])}; }
__device__ __forceinline__ void unpack8(u32x4 w, f32x4& a, f32x4& b) {
    a = (f32x4){__uint_as_float(w.x << 16), __uint_as_float(w.x & 0xffff0000u), __uint_as_float(w.y << 16), __uint_as_float(w.y & 0xffff0000u)};
    b = (f32x4){__uint_as_float(w.z << 16), __uint_as_float(w.z & 0xffff0000u), __uint_as_float(w.w << 16), __uint_as_float(w.w & 0xffff0000u)};
}
__device__ __forceinline__ u32x4 pack8(f32x4 v0, f32x4 v1) { u32x4 w; w.x = cvt_pk_bf16(v0[0], v0[1]); w.y = cvt_pk_bf16(v0[2], v0[3]); w.z = cvt_pk_bf16(v1[0], v1[1]); w.w = cvt_pk_bf16(v1[2], v1[3]); return w; }
#define EPI_ROWS(...) \
    _Pragma("unroll") for (int ai = 0; ai < 2; ++ai) _Pragma("unroll") for (int m = 0; m < 4; ++m) { const size_t row = (size_t)(row0 + ai * HALF + m * 16); \
        _Pragma("unroll") for (int bj = 0; bj < 2; ++bj) { const int col = col0 + bj * HALF; const f32x4 v0 = acc[ai][bj][m][0], v1 = acc[ai][bj][m][1]; __VA_ARGS__ } \
        asm volatile("" ::: "memory"); }
#define EPI_HEAD const int row0 = u.pm * BM + wr * 64 + fr, col0 = u.pn * BM + wc * 32 + 8 * fq;

constexpr int EP_ATT_TILE0 = 65, EP_LSEQ = 13;
struct EpiProj {
    static constexpr bool PERM = true, AFTER_DRAIN = false; static constexpr int MIDK = 0;
    bf16_t* O; int ldc; float* BA; int ba_tile; bf16_t* AQ; int tile0;
    __device__ __forceinline__ void operator()(const f32x4 (&acc)[2][2][4][2], const Unit& u, int wr, int wc, int fr, int fq) const {
        EPI_HEAD
        if (u.pn == ba_tile) {
            if (wc == 0) {
#pragma unroll
                for (int ai = 0; ai < 2; ++ai)
#pragma unroll
                    for (int m = 0; m < 4; ++m) { float* rp = BA + (size_t)(row0 + ai * HALF + m * 16) * 32 + 8 * fq; *(f32x4*)rp = acc[ai][0][m][0]; *(f32x4*)(rp + 4) = acc[ai][0][m][1]; }
            }
            return;
        }
        const int gt = tile0 + u.pn;
        if (gt >= EP_ATT_TILE0) {
            const int a = gt - EP_ATT_TILE0, which = a / 12, g = (a % 12) >> 2, hb = (a & 3) << 1, ld = 2 * g;
            bf16_t* base = AQ + ((size_t)((which * 3 + g) * 8 + hb) << (EP_LSEQ + 7)) + wc * 32 + 8 * fq;
#pragma unroll
            for (int ai = 0; ai < 2; ++ai)
#pragma unroll
                for (int m = 0; m < 4; ++m) { const int t = row0 + ai * HALF + m * 16; const int pos = ((t & ((1 << ld) - 1)) << (EP_LSEQ - ld)) + (t >> ld);
#pragma unroll
                    for (int bj = 0; bj < 2; ++bj) *(u32x4*)(base + ((size_t)bj << (EP_LSEQ + 7)) + (size_t)pos * 128) = pack8(acc[ai][bj][m][0], acc[ai][bj][m][1]);
                    asm volatile("" ::: "memory"); }
            return;
        }
        EPI_ROWS( *(u32x4*)(O + row * ldc + col) = pack8(v0, v1); )
    }
};
struct EpiGate1 {
    static constexpr bool PERM = true, AFTER_DRAIN = false; static constexpr int MIDK = 0;
    const bf16_t* G; int ldg; float* T; int ldt;
    __device__ __forceinline__ void operator()(const f32x4 (&acc)[2][2][4][2], const Unit& u, int wr, int wc, int fr, int fq) const {
        EPI_HEAD
        EPI_ROWS( f32x4 g0, g1; unpack8(*(const u32x4*)(G + row * ldg + col), g0, g1); float* tp = T + row * ldt + col; *(f32x4*)tp = sigm4(g0) * v0; *(f32x4*)(tp + 4) = sigm4(g1) * v1; )
    }
};
struct EpiGate2 {
    static constexpr bool PERM = true, AFTER_DRAIN = false; static constexpr int MIDK = 0;
    const bf16_t* G; int ldg; const float* T; int ldt; bf16_t* O; int ldo;
    __device__ __forceinline__ void operator()(const f32x4 (&acc)[2][2][4][2], const Unit& u, int wr, int wc, int fr, int fq) const {
        EPI_HEAD
        EPI_ROWS( f32x4 g0, g1; unpack8(*(const u32x4*)(G + row * ldg + col), g0, g1); const float* tp = T + row * ldt + col;
                  const f32x4 t0 = *(const f32x4*)tp, t1 = *(const f32x4*)(tp + 4); *(u32x4*)(O + row * ldo + col) = pack8(t0 + sigm4(g0) * v0, t1 + sigm4(g1) * v1); )
    }
};
struct EpiResid {
    static constexpr bool PERM = true, AFTER_DRAIN = false; static constexpr int MIDK = 0;
    const float* X; float* Y; int ldx;
    __device__ __forceinline__ void operator()(const f32x4 (&acc)[2][2][4][2], const Unit& u, int wr, int wc, int fr, int fq) const {
        EPI_HEAD
        EPI_ROWS( const float* xp = X + row * ldx + col; float* yp = Y + row * ldx + col; const f32x4 x0 = *(const f32x4*)xp, x1 = *(const f32x4*)(xp + 4); *(f32x4*)yp = x0 + v0; *(f32x4*)(yp + 4) = x1 + v1; )
    }
};
struct EpiRelu2 {
    static constexpr bool PERM = true, AFTER_DRAIN = false; static constexpr int MIDK = 0;
    bf16_t* O; int ldo;
    __device__ __forceinline__ void operator()(const f32x4 (&acc)[2][2][4][2], const Unit& u, int wr, int wc, int fr, int fq) const {
        EPI_HEAD
        EPI_ROWS( const f32x4 z = {0.f, 0.f, 0.f, 0.f}; const f32x4 r0 = __builtin_elementwise_max(v0, z), r1 = __builtin_elementwise_max(v1, z); *(u32x4*)(O + row * ldo + col) = pack8(r0 * r0, r1 * r1); )
    }
};
struct EpiF32 {
    static constexpr bool PERM = true, AFTER_DRAIN = false; static constexpr int MIDK = 0;
    float* O; int ldo;
    __device__ __forceinline__ void operator()(const f32x4 (&acc)[2][2][4][2], const Unit& u, int wr, int wc, int fr, int fq) const {
        EPI_HEAD
        EPI_ROWS( float* op = O + row * ldo + col; *(f32x4*)op = v0; *(f32x4*)(op + 4) = v1; )
    }
};
struct EpiPle {
    static constexpr bool PERM = true, AFTER_DRAIN = false; static constexpr int MIDK = 0;
    const float* X; const float* P; float* Y; int ldx;
    __device__ __forceinline__ void operator()(const f32x4 (&acc)[2][2][4][2], const Unit& u, int wr, int wc, int fr, int fq) const {
        EPI_HEAD
        EPI_ROWS( const float* xp = X + row * ldx + col; const float* pp = P + row * ldx + col; float* yp = Y + row * ldx + col;
                  const f32x4 x0 = *(const f32x4*)xp, x1 = *(const f32x4*)(xp + 4), p0 = *(const f32x4*)pp, p1 = *(const f32x4*)(pp + 4);
                  *(f32x4*)yp = x0 + sigm4(v0) * p0; *(f32x4*)(yp + 4) = x1 + sigm4(v1) * p1; )
    }
};

#define EPI_SSQ(SSQ_, ss_) do { float _s = (ss_); _s += __shfl_xor(_s, 16); _s += __shfl_xor(_s, 32); if (fq == 0) (SSQ_)[row * 64 + u.pn * 4 + wc] = _s; } while (0)
__device__ __forceinline__ float dot4(f32x4 a) { return (a[0] * a[0] + a[1] * a[1]) + (a[2] * a[2] + a[3] * a[3]); }
template <bool XF32, bool RS = false> struct EpiResidN {
    static constexpr bool PERM = true, AFTER_DRAIN = false; static constexpr int MIDK = 0;
    const void* X; bf16_t* Y; int ldx; float* SSQ; const float* rstd;
    __device__ __forceinline__ void operator()(const f32x4 (&acc)[2][2][4][2], const Unit& u, int wr, int wc, int fr, int fq) const {
        EPI_HEAD
#pragma unroll
        for (int ai = 0; ai < 2; ++ai) {
            f32x4 xv[4][2][2]; float r2[4];
            if constexpr (RS) {
#pragma unroll
                for (int m = 0; m < 4; ++m) r2[m] = rstd[row0 + ai * HALF + m * 16];
            }
#pragma unroll
            for (int m = 0; m < 4; ++m)
#pragma unroll
                for (int bj = 0; bj < 2; ++bj) { const size_t row = (size_t)(row0 + ai * HALF + m * 16); const int col = col0 + bj * HALF;
                    if constexpr (XF32) { const float* xp = (const float*)X + row * ldx + col; xv[m][bj][0] = *(const f32x4*)xp; xv[m][bj][1] = *(const f32x4*)(xp + 4); }
                    else unpack8(*(const u32x4*)((const bf16_t*)X + kt_off(row, col, ldx)), xv[m][bj][0], xv[m][bj][1]); }
#pragma unroll
            for (int m = 0; m < 4; ++m) { const size_t row = (size_t)(row0 + ai * HALF + m * 16); float ss = 0.f;
#pragma unroll
                for (int bj = 0; bj < 2; ++bj) { const int col = col0 + bj * HALF;
                    f32x4 y0, y1; if constexpr (RS) { const float q = r2[m] * r2[m]; y0 = xv[m][bj][0] + acc[ai][bj][m][0] * q; y1 = xv[m][bj][1] + acc[ai][bj][m][1] * q; } else { y0 = xv[m][bj][0] + acc[ai][bj][m][0]; y1 = xv[m][bj][1] + acc[ai][bj][m][1]; }
                    *(u32x4*)(Y + kt_off(row, col, ldx)) = pack8(y0, y1); ss += dot4(y0) + dot4(y1); }
                EPI_SSQ(SSQ, ss); }
            asm volatile("" ::: "memory"); }
    }
};
struct EpiRelu2S {
    static constexpr bool PERM = true, AFTER_DRAIN = false; static constexpr int MIDK = 0;
    bf16_t* O; int ldo;
    __device__ __forceinline__ void operator()(const f32x4 (&acc)[2][2][4][2], const Unit& u, int wr, int wc, int fr, int fq) const {
        EPI_HEAD
#pragma unroll
        for (int ai = 0; ai < 2; ++ai)
#pragma unroll
            for (int m = 0; m < 4; ++m) { const size_t row = (size_t)(row0 + ai * HALF + m * 16);
#pragma unroll
                for (int bj = 0; bj < 2; ++bj) { const int col = col0 + bj * HALF; const f32x4 z = {0.f, 0.f, 0.f, 0.f};
                    const f32x4 r0 = __builtin_elementwise_max(acc[ai][bj][m][0], z), r1 = __builtin_elementwise_max(acc[ai][bj][m][1], z);
                    *(u32x4*)(O + kt_off(row, col, ldo)) = pack8(r0 * r0, r1 * r1); } }
    }
};
struct EpiF32N {
    static constexpr bool PERM = true, AFTER_DRAIN = false; static constexpr int MIDK = 0;
    bf16_t* O; int ldo; float* SSQ;
    __device__ __forceinline__ void operator()(const f32x4 (&acc)[2][2][4][2], const Unit& u, int wr, int wc, int fr, int fq) const {
        EPI_HEAD
#pragma unroll
        for (int ai = 0; ai < 2; ++ai)
#pragma unroll
            for (int m = 0; m < 4; ++m) { const size_t row = (size_t)(row0 + ai * HALF + m * 16); float ss = 0.f;
#pragma unroll
                for (int bj = 0; bj < 2; ++bj) { const int col = col0 + bj * HALF; const f32x4 v0 = acc[ai][bj][m][0], v1 = acc[ai][bj][m][1];
                    *(u32x4*)(O + row * ldo + col) = pack8(v0, v1); ss += dot4(v0) + dot4(v1); }
                EPI_SSQ(SSQ, ss);
                asm volatile("" ::: "memory"); }
    }
};
struct EpiPleN {
    static constexpr bool PERM = true, AFTER_DRAIN = false; static constexpr int MIDK = 0;
    const bf16_t* X; const bf16_t* P; bf16_t* Y; int ldx; const float* rstd; const float* rstdp; const float* gp;
    __device__ __forceinline__ void operator()(const f32x4 (&acc)[2][2][4][2], const Unit& u, int wr, int wc, int fr, int fq) const {
        EPI_HEAD
        f32x4 gv[2][2]; float rs[2][4], rp[2][4];
#pragma unroll
        for (int bj = 0; bj < 2; ++bj) { gv[bj][0] = *(const f32x4*)(gp + col0 + bj * HALF); gv[bj][1] = *(const f32x4*)(gp + col0 + bj * HALF + 4); }
#pragma unroll
        for (int ai = 0; ai < 2; ++ai)
#pragma unroll
            for (int m = 0; m < 4; ++m) { rs[ai][m] = rstd[row0 + ai * HALF + m * 16]; rp[ai][m] = rstdp[row0 + ai * HALF + m * 16]; }
#pragma unroll
        for (int ai = 0; ai < 2; ++ai)
#pragma unroll
          for (int mh = 0; mh < 2; ++mh) {
            u32x4 wp[2][2], wx[2][2];
#pragma unroll
            for (int mm = 0; mm < 2; ++mm)
#pragma unroll
                for (int bj = 0; bj < 2; ++bj) { const int m = 2 * mh + mm; const size_t row = (size_t)(row0 + ai * HALF + m * 16); const int col = col0 + bj * HALF; wp[mm][bj] = *(const u32x4*)(P + row * ldx + col); wx[mm][bj] = *(const u32x4*)(X + kt_off(row, col, ldx)); }
#pragma unroll
            for (int mm = 0; mm < 2; ++mm)
#pragma unroll
                for (int bj = 0; bj < 2; ++bj) { const int m = 2 * mh + mm; const size_t row = (size_t)(row0 + ai * HALF + m * 16); const int col = col0 + bj * HALF; f32x4 p0, p1, x0, x1; unpack8(wp[mm][bj], p0, p1); unpack8(wx[mm][bj], x0, x1); const float s = rs[ai][m], q = rp[ai][m];
                    *(u32x4*)(Y + row * ldx + col) = pack8(x0 + sigm4(acc[ai][bj][m][0] * s) * (p0 * q * gv[bj][0]), x1 + sigm4(acc[ai][bj][m][1] * s) * (p1 * q * gv[bj][1])); }
            asm volatile("" ::: "memory"); }
    }
};

struct EpiMerge {
    static constexpr bool PERM = true, AFTER_DRAIN = false; static constexpr int MIDK = 32;
    const bf16_t* GA; const bf16_t* GB; int ldg; bf16_t* O; int ldo;
    __device__ __forceinline__ void mid(f32x4 (&acc)[2][2][4][2], const Unit& u, int wr, int wc, int fr, int fq) const {
        const bf16_t* ga = GA + (size_t)(u.pm * BM + wr * 64 + fr) * ldg + u.pn * BM + wc * 32 + 8 * fq; const size_t gd = GB - GA;
#pragma unroll
        for (int ai = 0; ai < 2; ++ai) {
            u32x4 wa[4][2], wb[4][2];
#pragma unroll
            for (int m = 0; m < 4; ++m)
#pragma unroll
                for (int bj = 0; bj < 2; ++bj) { const bf16_t* p = ga + (size_t)(ai * HALF + m * 16) * ldg + bj * HALF; wa[m][bj] = *(const u32x4*)p; wb[m][bj] = *(const u32x4*)(p + gd); }
#pragma unroll
            for (int m = 0; m < 4; ++m)
#pragma unroll
                for (int bj = 0; bj < 2; ++bj) { f32x4 a0, a1, b0, b1; unpack8(wa[m][bj], a0, a1); unpack8(wb[m][bj], b0, b1);
#pragma unroll
                    for (int q = 0; q < 4; ++q) { acc[ai][bj][m][0][q] *= (1.0f + __builtin_amdgcn_exp2f(-1.4426950408889634f * a0[q])) * sigm(b0[q]); acc[ai][bj][m][1][q] *= (1.0f + __builtin_amdgcn_exp2f(-1.4426950408889634f * a1[q])) * sigm(b1[q]); } }
            asm volatile("" ::: "memory"); }
    }
    __device__ __forceinline__ void operator()(const f32x4 (&acc)[2][2][4][2], const Unit& u, int wr, int wc, int fr, int fq) const {
        EPI_HEAD
#pragma unroll
        for (int ai = 0; ai < 2; ++ai) {
            u32x4 wa[4][2];
#pragma unroll
            for (int m = 0; m < 4; ++m)
#pragma unroll
                for (int bj = 0; bj < 2; ++bj) wa[m][bj] = *(const u32x4*)(GA + (size_t)(row0 + ai * HALF + m * 16) * ldg + col0 + bj * HALF);
#pragma unroll
            for (int m = 0; m < 4; ++m)
#pragma unroll
                for (int bj = 0; bj < 2; ++bj) { f32x4 g0, g1; unpack8(wa[m][bj], g0, g1); *(u32x4*)(O + kt_off((size_t)(row0 + ai * HALF + m * 16), col0 + bj * HALF, ldo)) = pack8(sigm4(g0) * acc[ai][bj][m][0], sigm4(g1) * acc[ai][bj][m][1]); }
            asm volatile("" ::: "memory"); }
    }
};

struct SegOrder : StaticOrder {
    __device__ bool next(int i, Unit& u) const { const bool r = StaticOrder::next(i >> 1, u); u.seg = i & 1; return r; }
};
template <class Epi, class Sched, bool ALIGN_EPI = false, bool SP2 = false>
__device__ __forceinline__ void gemm_phase(PG8_LAS unsigned char* lds, const Gemm g, const Sched& S, const Epi& E) {
    const int tid = otid(), wid = __builtin_amdgcn_readfirstlane(tid >> 6), lane = tid & 63, wr = wid >> 2, wc = wid & 3, fr = lane & 15, fq = lane >> 4;
    const int K = g.K, nt = K / BK;
    constexpr bool SEG = Epi::MIDK > 0;
#define PG8_KOFF(u_) ((SEG && (u_).seg) ? (size_t)Epi::MIDK * HTB : (size_t)0)
#define PG8_NT(u_) (SEG ? ((u_).seg ? nt - Epi::MIDK : Epi::MIDK) : nt)
    unsigned voffA[2], voffB[2];
#pragma unroll
    for (int i = 0; i < 2; ++i) { int R, C; stage_rc(tid * 16 + i * 8192, R, C); const int Rb = Epi::PERM ? ((R & ~31) + perm32(R & 31)) : R;
        voffA[i] = (unsigned)(R * BK + C) * 2u; voffB[i] = (unsigned)(Rb * BK + C) * 2u; }
    const size_t kstep = (size_t)HTB;
    const size_t hstep = (size_t)(g.ld / BK) * HTB;
    const size_t tstep = 2 * hstep;
    const unsigned ldsw = (unsigned)wid * 1024u;
    const int aoff = lds_byte(wr * 64 + fr, fq * 8), boff = lds_byte(wc * 32 + fr, fq * 8);
#define PG8_SA(b, h) (((b) * 2 + (h)) * HTB)
#define PG8_SB(b, h) ((4 + (b) * 2 + (h)) * HTB)
#define PG8_STAGE(bufoff, gbase, voff) do { _Pragma("unroll") for (int _i = 0; _i < 2; ++_i) \
        __builtin_amdgcn_global_load_lds((const unsigned*)((const char*)(gbase) + (voff)[_i]), (PG8_LAS unsigned*)(lds + (bufoff) + ldsw + _i * 8192), 16, 0, 0); } while (0)
#define PG8_LDA(dst, b, h) do { _Pragma("unroll") for (int m = 0; m < 4; ++m) _Pragma("unroll") for (int k = 0; k < 2; ++k) dst[m][k] = *(const PG8_LAS bf16x8*)(lds + PG8_SA(b, h) + aoff + m * 2048 + k * 1024); } while (0)
#define PG8_LDB(dst, b, h) do { _Pragma("unroll") for (int n = 0; n < 2; ++n) _Pragma("unroll") for (int k = 0; k < 2; ++k) dst[n][k] = *(const PG8_LAS bf16x8*)(lds + PG8_SB(b, h) + boff + n * 2048 + k * 1024); } while (0)
#define PG8_MMA(ai, bj, At, Bt) do { __builtin_amdgcn_s_setprio(1); _Pragma("unroll") for (int m = 0; m < 4; ++m) _Pragma("unroll") for (int n = 0; n < 2; ++n) _Pragma("unroll") for (int k = 0; k < 2; ++k) \
        acc[ai][bj][m][n] = __builtin_amdgcn_mfma_f32_16x16x32_bf16(Bt[n][k], At[m][k], acc[ai][bj][m][n], 0, 0, 0); __builtin_amdgcn_s_setprio(0); } while (0)
#define PG8_WAIT_V(n) asm volatile("s_waitcnt vmcnt(" #n ")" ::: "memory")
#define PG8_WAIT_L(n) asm volatile("s_waitcnt lgkmcnt(" #n ")" ::: "memory")
#define PG8_BAR __builtin_amdgcn_s_barrier()
#define PG8_SCHED __builtin_amdgcn_sched_barrier(0)
    Unit cur, nxt; int ui = 0;
    if (!S.next(0, cur)) return;
    f32x4 acc[2][2][4][2];
#pragma unroll
    for (int a = 0; a < 2; ++a)
#pragma unroll
        for (int b = 0; b < 2; ++b)
#pragma unroll
            for (int m = 0; m < 4; ++m)
#pragma unroll
                for (int n = 0; n < 2; ++n) acc[a][b][m][n] = (f32x4){0.f, 0.f, 0.f, 0.f};
    bf16x8 At[4][2], B0[2][2], B1[2][2];
    const char* cA = (const char*)g.A + (size_t)cur.pm * tstep + PG8_KOFF(cur); const char* cB = (const char*)g.Bt + (size_t)cur.pn * tstep + PG8_KOFF(cur);
    S.a_ready(cur);
    if constexpr (SP2) {
        PG8_STAGE(PG8_SB(0, 0), cB, voffB); PG8_STAGE(PG8_SB(0, 1), cB + hstep, voffB); PG8_STAGE(PG8_SA(0, 0), cA, voffA); PG8_STAGE(PG8_SA(0, 1), cA + hstep, voffA);
        if (wr == 1) PG8_BAR;
        PG8_WAIT_V(2); PG8_BAR;
        PG8_STAGE(PG8_SB(1, 0), cB + kstep, voffB); PG8_STAGE(PG8_SA(1, 0), cA + kstep, voffA); PG8_STAGE(PG8_SB(1, 1), cB + hstep + kstep, voffB);
        PG8_WAIT_V(6); PG8_BAR;
    } else {
        PG8_STAGE(PG8_SB(0, 0), cB, voffB); PG8_STAGE(PG8_SA(0, 0), cA, voffA); PG8_STAGE(PG8_SB(0, 1), cB + hstep, voffB); PG8_STAGE(PG8_SA(0, 1), cA + hstep, voffA);
        if (wr == 1) PG8_BAR;
        PG8_WAIT_V(4); PG8_BAR;
        PG8_STAGE(PG8_SB(1, 0), cB + kstep, voffB); PG8_STAGE(PG8_SA(1, 0), cA + kstep, voffA); PG8_STAGE(PG8_SB(1, 1), cB + hstep + kstep, voffB);
        PG8_WAIT_V(6); PG8_BAR;
    }
    for (;;) {
        const bool has_next = S.next(ui + 1, nxt);
        const char* nA = has_next ? (const char*)g.A + (size_t)nxt.pm * tstep + PG8_KOFF(nxt) : cA; const char* nB = has_next ? (const char*)g.Bt + (size_t)nxt.pn * tstep + PG8_KOFF(nxt) : cB;
        const int ntu = PG8_NT(cur);
        for (int t = 0; t < ntu; t += 2) {
            const bool last = (t == ntu - 2);
            const char* a1 = cA + (size_t)(t + 1) * kstep;
            const char* a2 = last ? nA : cA + (size_t)(t + 2) * kstep; const char* b2 = last ? nB : cB + (size_t)(t + 2) * kstep;
            const char* a3 = a2 + kstep; const char* b3 = b2 + kstep;
            if (last && has_next) S.a_ready(nxt);
            if constexpr (SP2) {
            PG8_LDB(B0, 0, 0); PG8_LDB(B1, 0, 1); PG8_SCHED; PG8_LDA(At, 0, 0); PG8_STAGE(PG8_SA(1, 1), a1 + hstep, voffA);
            PG8_WAIT_V(8); PG8_WAIT_L(0); PG8_BAR; PG8_MMA(0, 0, At, B0); PG8_MMA(0, 1, At, B1); PG8_BAR; PG8_SCHED;
            PG8_LDA(At, 0, 1); PG8_STAGE(PG8_SB(0, 0), b2, voffB); PG8_STAGE(PG8_SB(0, 1), b2 + hstep, voffB); PG8_STAGE(PG8_SA(0, 0), a2, voffA);
            PG8_WAIT_V(8); PG8_WAIT_L(0); PG8_BAR; PG8_MMA(1, 0, At, B0); PG8_MMA(1, 1, At, B1); PG8_BAR; PG8_SCHED;
            PG8_LDB(B0, 1, 0); PG8_LDB(B1, 1, 1); PG8_SCHED; PG8_LDA(At, 1, 0); PG8_STAGE(PG8_SA(0, 1), a2 + hstep, voffA);
            PG8_WAIT_V(8); PG8_WAIT_L(0); PG8_BAR; PG8_MMA(0, 0, At, B0); PG8_MMA(0, 1, At, B1); PG8_BAR; PG8_SCHED;
            PG8_LDA(At, 1, 1); PG8_STAGE(PG8_SB(1, 0), b3, voffB); PG8_STAGE(PG8_SB(1, 1), b3 + hstep, voffB); PG8_STAGE(PG8_SA(1, 0), a3, voffA);
            PG8_WAIT_V(8); PG8_WAIT_L(0); PG8_BAR; PG8_MMA(1, 0, At, B0); PG8_MMA(1, 1, At, B1); PG8_BAR; PG8_SCHED;
            } else {
            PG8_LDB(B0, 0, 0); PG8_SCHED; PG8_LDA(At, 0, 0); PG8_STAGE(PG8_SA(1, 1), a1 + hstep, voffA);
            PG8_WAIT_L(8); PG8_BAR; PG8_WAIT_L(0); PG8_MMA(0, 0, At, B0); PG8_BAR; PG8_SCHED;
            PG8_LDB(B1, 0, 1); PG8_STAGE(PG8_SB(0, 0), b2, voffB);
            PG8_BAR; PG8_WAIT_L(0); PG8_MMA(0, 1, At, B1); PG8_BAR;
            PG8_LDA(At, 0, 1); PG8_STAGE(PG8_SA(0, 0), a2, voffA);
            PG8_BAR; PG8_WAIT_L(0); PG8_MMA(1, 0, At, B0); PG8_BAR; PG8_SCHED;
            PG8_STAGE(PG8_SB(0, 1), b2 + hstep, voffB);
            PG8_WAIT_V(6); PG8_BAR; PG8_MMA(1, 1, At, B1); PG8_BAR;
            PG8_LDB(B0, 1, 0); PG8_SCHED; PG8_LDA(At, 1, 0); PG8_STAGE(PG8_SA(0, 1), a2 + hstep, voffA);
            PG8_WAIT_L(8); PG8_BAR; PG8_WAIT_L(0); PG8_MMA(0, 0, At, B0); PG8_BAR; PG8_SCHED;
            PG8_LDB(B1, 1, 1); PG8_STAGE(PG8_SB(1, 0), b3, voffB);
            PG8_BAR; PG8_WAIT_L(0); PG8_MMA(0, 1, At, B1); PG8_BAR;
            PG8_LDA(At, 1, 1); PG8_STAGE(PG8_SA(1, 0), a3, voffA);
            PG8_BAR; PG8_WAIT_L(0); PG8_MMA(1, 0, At, B0); PG8_BAR; PG8_SCHED;
            PG8_STAGE(PG8_SB(1, 1), b3 + hstep, voffB);
            PG8_WAIT_V(6); PG8_BAR; PG8_MMA(1, 1, At, B1); PG8_BAR;
            }
        }
        if constexpr (ALIGN_EPI) { if (wr == 0) PG8_BAR; }
        if constexpr (SEG) { if (cur.seg == 0) E.mid(acc, cur, wr, wc, fr, fq); else E(acc, cur, wr, wc, fr, fq); }
        else if constexpr (!Epi::AFTER_DRAIN) { E(acc, cur, wr, wc, fr, fq); S.done(cur); }
        if (!has_next) break;
        if (!(SEG && cur.seg == 0))
#pragma unroll
        for (int a = 0; a < 2; ++a)
#pragma unroll
            for (int b = 0; b < 2; ++b)
#pragma unroll
                for (int m = 0; m < 4; ++m)
#pragma unroll
                    for (int n = 0; n < 2; ++n) acc[a][b][m][n] = (f32x4){0.f, 0.f, 0.f, 0.f};
        cur = nxt; cA = nA; cB = nB; ++ui;
        if constexpr (ALIGN_EPI) { if (wr == 1) PG8_BAR; }
    }
    PG8_WAIT_V(0);
    if constexpr (!ALIGN_EPI) { if (wr == 0) PG8_BAR; }
    PG8_BAR;
    if constexpr (Epi::AFTER_DRAIN) { E.fused(acc, cur, wr, wc, fr, fq, lds, wid, lane); S.done(cur); }
#undef PG8_SA
#undef PG8_SB
#undef PG8_STAGE
#undef PG8_LDA
#undef PG8_LDB
#undef PG8_MMA
#undef PG8_WAIT_V
#undef PG8_WAIT_L
#undef PG8_BAR
#undef PG8_SCHED
#undef PG8_KOFF
#undef PG8_NT
}
}

namespace swa {
constexpr int D = 128; constexpr float THR = 8.f; constexpr bool WSKIP = true;
constexpr float SCALE = 0.08838834764831845f;
constexpr int NW = 8, QBLK = 32, KVBLK = 64, QB = NW * QBLK;
constexpr int SHM_V = KVBLK * D * 2, SHM_K = KVBLK * D * 2;
constexpr int LDS_BYTES = 2 * SHM_V + 2 * SHM_K + NW * 64 * 4;

typedef unsigned short bf16;
typedef short bf16x8 __attribute__((ext_vector_type(8)));
typedef short s16x4 __attribute__((ext_vector_type(4)));
typedef float f32x16 __attribute__((ext_vector_type(16)));
typedef float f32x4 __attribute__((ext_vector_type(4)));
typedef unsigned u32x4 __attribute__((ext_vector_type(4)));
template <class A, class Bt> struct same_t { static constexpr bool v = false; };
template <class A> struct same_t<A, A> { static constexpr bool v = true; };

#define KSWZ(row, colB) ((row) * 256 + ((colB) ^ (((row) & 7) << 4)))
#define SBAR() __builtin_amdgcn_sched_barrier(0)
__device__ __forceinline__ int v_st(int k, int c) { const int kk = (k & ~0xC) | ((k & 4) << 1) | ((k & 8) >> 1); return ((kk >> 3) * 4 + (c >> 5)) * 512 + ((kk & 7) * 32 + (c & 31)) * 2; }
__device__ __forceinline__ int v_rd_base(int lane) { return ((lane & 3) << 3) | (((lane >> 2) & 3) << 6) | (((lane >> 4) & 1) << 5) | (((lane >> 5) & 1) << 8); }
constexpr int v_rd_off(int d0, int ks, int half) { return d0 * 512 + ks * 4096 + half * 2048; }
__device__ __forceinline__ int crow(int r, int hi) { return (r & 3) + 8 * (r >> 2) + 4 * hi; }
typedef float f32x2_t __attribute__((ext_vector_type(2))); typedef __bf16 bf16x2_t __attribute__((ext_vector_type(2)));
__device__ __forceinline__ unsigned cvtpk(float lo, float hi) { const f32x2_t v = {lo, hi}; const bf16x2_t b = __builtin_convertvector(v, bf16x2_t); return __builtin_bit_cast(unsigned, b); }
__device__ __forceinline__ bf16x8 pack8(f32x4 a, f32x4 b) {
    u32x4 w = {cvtpk(a[0], a[1]), cvtpk(a[2], a[3]), cvtpk(b[0], b[1]), cvtpk(b[2], b[3])};
    return *reinterpret_cast<bf16x8*>(&w);
}
template <class T> __device__ __forceinline__ bf16x8 load8(const T* p) {
    if constexpr (same_t<T, float>::v) { return pack8(*(const f32x4*)p, *(const f32x4*)(p + 4)); }
    else { return *reinterpret_cast<const bf16x8*>(p); }
}
__device__ __forceinline__ void mask_tile(f32x16& p0, f32x16& p1, int dq, unsigned W) {
    const float NEG = -__builtin_inff();
#pragma unroll
    for (int r = 0; r < 16; ++r) {
        const int c = (r & 3) + 8 * (r >> 2);
        if ((unsigned)(dq - c) >= W) p0[r] = NEG;
        if ((unsigned)(dq - c - 32) >= W) p1[r] = NEG;
    }
}
__device__ __forceinline__ void partialSM(f32x16& p0, f32x16& p1, float& m_reg, float& mn, float& alpha) {
    float pmax = p0[0]; for (int r = 1; r < 16; ++r) pmax = fmaxf(pmax, p0[r]); for (int r = 0; r < 16; ++r) pmax = fmaxf(pmax, p1[r]);
    { auto rr = __builtin_amdgcn_permlane32_swap(__float_as_uint(pmax), __float_as_uint(pmax), false, false);
      pmax = fmaxf(__uint_as_float(rr[0]), __uint_as_float(rr[1])); }
    constexpr float C2 = 1.4426950408889634f * SCALE;
    if (__builtin_expect(__all((pmax - m_reg) * SCALE <= THR), 1)) { mn = m_reg; alpha = 1.f; }
    else { mn = fmaxf(m_reg, pmax); alpha = __builtin_amdgcn_exp2f((m_reg - mn) * C2); m_reg = mn; }
    const float mnL = -mn * C2;
    for (int r = 0; r < 16; ++r) p0[r] = fmaf(p0[r], C2, mnL); for (int r = 0; r < 16; ++r) p1[r] = fmaf(p1[r], C2, mnL);
    for (int r = 0; r < 16; ++r) p0[r] = __builtin_amdgcn_exp2f(p0[r]);
}
__device__ __forceinline__ void finishSM(f32x16& p0, f32x16& p1, float alpha, float& l_reg, bf16x8& pa0, bf16x8& pa1, bf16x8& pa2, bf16x8& pa3) {
    for (int r = 0; r < 16; ++r) p1[r] = __builtin_amdgcn_exp2f(p1[r]);
    float ps = 0; for (int r = 0; r < 16; ++r) ps += p0[r]; for (int r = 0; r < 16; ++r) ps += p1[r];
    { auto rr = __builtin_amdgcn_permlane32_swap(__float_as_uint(ps), __float_as_uint(ps), false, false);
      ps = __uint_as_float(rr[0]) + __uint_as_float(rr[1]); }
    l_reg = l_reg * alpha + ps;
#define PK4(P, B_, OUT) do { unsigned a0 = cvtpk(P[B_+0], P[B_+1]), a1 = cvtpk(P[B_+2], P[B_+3]);                          \
        unsigned b0 = cvtpk(P[B_+4], P[B_+5]), b1 = cvtpk(P[B_+6], P[B_+7]);                                             \
        auto r0 = __builtin_amdgcn_permlane32_swap(a0, b0, false, false); auto r1 = __builtin_amdgcn_permlane32_swap(a1, b1, false, false); \
        u32x4 w = {r0[0], r1[0], r0[1], r1[1]}; OUT = *reinterpret_cast<bf16x8*>(&w); } while (0)
    PK4(p0, 0, pa0); PK4(p0, 8, pa1); PK4(p1, 0, pa2); PK4(p1, 8, pa3);
#undef PK4
}
template <int KB, bool SK>
__device__ __forceinline__ void qkt(f32x16& p0, f32x16& p1, const char* K_lds, int r32, int hi, const bf16x8* qr, bool act) {
    if (SK && !act) { const float NEG = -__builtin_inff();
#pragma unroll
        for (int r = 0; r < 16; ++r) { p0[r] = NEG; p1[r] = NEG; } return; }
    p0 = f32x16{}; p1 = f32x16{};
    const char* kb[4];
#pragma unroll
    for (int dd = 0; dd < 4; ++dd) kb[dd] = K_lds + KB * SHM_K + KSWZ(r32, (dd * 16 + hi * 8) * 2);
#pragma unroll
    for (int d0 = 0; d0 < 8; ++d0) { const char* a = kb[d0 & 3] + (d0 >> 2) * 128;
        bf16x8 b0 = *reinterpret_cast<const bf16x8*>(a);
        bf16x8 b1 = *reinterpret_cast<const bf16x8*>(a + 32 * 256);
        p0 = __builtin_amdgcn_mfma_f32_32x32x16_bf16(b0, qr[d0], p0, 0, 0, 0);
        p1 = __builtin_amdgcn_mfma_f32_32x32x16_bf16(b1, qr[d0], p1, 0, 0, 0); }
}
template <int VB, bool SK>
__device__ __forceinline__ void pv_tile(f32x16* o, int vb0, bf16x8 pa0, bf16x8 pa1, bf16x8 pa2, bf16x8 pa3, bool act) {
    if (SK && !act) return;
#define TRRD(dst, off) asm volatile("ds_read_b64_tr_b16 %0, %1 offset:%2" : "=&v"(dst) : "v"(vb0), "i"(off) : "memory")
#define PV_D0(d0) do { s16x4 l0, l1, l2, l3, h0, h1, h2, h3; constexpr int b_ = VB * SHM_V + v_rd_off(d0, 0, 0);     \
        TRRD(l0, b_); TRRD(h0, b_ + 2048); TRRD(l1, b_ + 4096); TRRD(h1, b_ + 6144); TRRD(l2, b_ + 8192); TRRD(h2, b_ + 10240); TRRD(l3, b_ + 12288); TRRD(h3, b_ + 14336); \
        asm volatile("s_waitcnt lgkmcnt(0)" ::: "memory"); SBAR();                 \
        o[d0] = __builtin_amdgcn_mfma_f32_32x32x16_bf16(pa0, (bf16x8){l0[0], l0[1], l0[2], l0[3], h0[0], h0[1], h0[2], h0[3]}, o[d0], 0, 0, 0);   \
        o[d0] = __builtin_amdgcn_mfma_f32_32x32x16_bf16(pa1, (bf16x8){l1[0], l1[1], l1[2], l1[3], h1[0], h1[1], h1[2], h1[3]}, o[d0], 0, 0, 0);   \
        o[d0] = __builtin_amdgcn_mfma_f32_32x32x16_bf16(pa2, (bf16x8){l2[0], l2[1], l2[2], l2[3], h2[0], h2[1], h2[2], h2[3]}, o[d0], 0, 0, 0);   \
        o[d0] = __builtin_amdgcn_mfma_f32_32x32x16_bf16(pa3, (bf16x8){l3[0], l3[1], l3[2], l3[3], h3[0], h3[1], h3[2], h3[3]}, o[d0], 0, 0, 0); } while (0)
    PV_D0(0); PV_D0(1); PV_D0(2); PV_D0(3);
#undef PV_D0
#undef TRRD
}

template <class TIn, class TOut> struct BlockRef { const TIn* Q; const TIn* K; const TIn* V; TOut* O; float* LSE; int P0, rs, ors, lrs; };
template <class TIn> struct Seam {
    bf16x8 qr[8];
    bf16x8 st_v0, st_v1, st_k0, st_k1; f32x4 sf0, sf1, sf2, sf3;
    f32x4 tq[16];
};
__device__ __forceinline__ int swa_jlo(int P0, int W) { const int lowk = P0 - W + 1; return lowk > 0 ? lowk / KVBLK : 0; }
#define ROW(p, k0, rr, RS_) ((p) + (size_t)((k0) + (rr)) * (RS_) + sc)
#define VMW() asm volatile("s_waitcnt vmcnt(0)" ::: "memory")
#define VMWN(n) asm volatile("s_waitcnt vmcnt(%0)" :: "i"(n) : "memory")
#define SLOAD_H(Kp, Vp, k0, RS_) do { S.st_v0 = load8<TIn>(ROW(Vp, k0, sr, RS_)); S.st_v1 = load8<TIn>(ROW(Vp, k0, 32 + sr, RS_));              \
                         S.st_k0 = load8<TIn>(ROW(Kp, k0, sr, RS_)); S.st_k1 = load8<TIn>(ROW(Kp, k0, 32 + sr, RS_)); } while (0)
#define SWRITE_HK(bf) do { *(bf16x8*)(K_lds + (bf) * SHM_K + kws) = S.st_k0; *(bf16x8*)(K_lds + (bf) * SHM_K + kws + 32 * 256) = S.st_k1; } while (0)
#define SWRITE_HV(bf) do { *(bf16x8*)(V_lds + (bf) * SHM_V + vst0) = S.st_v0; *(bf16x8*)(V_lds + (bf) * SHM_V + vst1) = S.st_v1; } while (0)
#define SWRITE_H(bf) do { SWRITE_HV(bf); SWRITE_HK(bf); } while (0)
#define SLOAD_F(p, k0, RS_) do { S.sf0 = *(const f32x4*)ROW(p, k0, sr, RS_); S.sf1 = *(const f32x4*)(ROW(p, k0, sr, RS_) + 4);                \
                            S.sf2 = *(const f32x4*)ROW(p, k0, 32 + sr, RS_); S.sf3 = *(const f32x4*)(ROW(p, k0, 32 + sr, RS_) + 4); } while (0)
#define SWRITE_KF(bf) do { *(bf16x8*)(K_lds + (bf) * SHM_K + kws) = pack8(S.sf0, S.sf1); *(bf16x8*)(K_lds + (bf) * SHM_K + kws + 32 * 256) = pack8(S.sf2, S.sf3); } while (0)
#define SWRITE_VF(bf) do { *(bf16x8*)(V_lds + (bf) * SHM_V + vst0) = pack8(S.sf0, S.sf1); *(bf16x8*)(V_lds + (bf) * SHM_V + vst1) = pack8(S.sf2, S.sf3); } while (0)
template <class TIn, class TOut>
__device__ __forceinline__ void causal_swa_prime(const BlockRef<TIn, TOut>& cur, int W, char* lds, Seam<TIn>& S) {
    constexpr bool F32 = same_t<TIn, float>::v;
    const int tid = otid(), wid = __builtin_amdgcn_readfirstlane(tid >> 6), lane = tid & 63, r32 = lane & 31, hi = lane >> 5;
    const int sr = tid >> 4, sc = (tid & 15) * 8, kws = KSWZ(sr, sc * 2); char* K_lds = lds + 2 * SHM_V;
    const int kb0 = swa_jlo(cur.P0, W) * KVBLK;
    for (int d0 = 0; d0 < 8; ++d0) S.qr[d0] = load8<TIn>(cur.Q + (size_t)(wid * QBLK + r32) * cur.rs + d0 * 16 + hi * 8);
    if constexpr (F32) { SLOAD_F((const float*)cur.K, kb0, cur.rs); VMW(); SWRITE_KF(0); SBAR(); SLOAD_F((const float*)cur.V, kb0, cur.rs); }
    else { SLOAD_H(cur.K, cur.V, kb0, cur.rs); VMW(); SWRITE_HK(0); }
    __syncthreads();
}
template <class TIn, class TOut>
__device__ __forceinline__ void causal_swa_block(const BlockRef<TIn, TOut>& cur, const BlockRef<TIn, TOut>& nxt, int skv, int W, char* lds, Seam<TIn>& S) {
    constexpr bool F32 = same_t<TIn, float>::v;
    const int tid = otid(), wid = __builtin_amdgcn_readfirstlane(tid >> 6), lane = tid & 63, r32 = lane & 31, hi = lane >> 5;
    const int j_lo = swa_jlo(cur.P0, W);
    int j_hi = (cur.P0 + QB - 1) / KVBLK + 1; if (j_hi > skv / KVBLK) j_hi = skv / KVBLK;
    const int NT = j_hi - j_lo;
    const int kbn = swa_jlo(nxt.P0, W) * KVBLK;
    const int qlo = cur.P0 + wid * QBLK, qm = qlo + r32 - 4 * hi;
    char* V_lds = lds; char* K_lds = lds + 2 * SHM_V;
    float* ws = (float*)(lds + 2 * SHM_V + 2 * SHM_K) + wid * 64; float* li_l = ws, * al_l = ws + 32;
    float m_reg = -1e30f, l_reg = 0; f32x16 o[4] = {};
    const int sr = tid >> 4, sc = (tid & 15) * 8, vst0 = v_st(sr, sc), vst1 = v_st(32 + sr, sc), kws = KSWZ(sr, sc * 2);
    const int vb0 = (int)(uintptr_t)V_lds + v_rd_base(lane);
    const TIn* Kh = cur.K; const TIn* Vh = cur.V;
#define RESC(a) do { if (__any((a) < 1.f)) { if (hi == 0) al_l[r32] = (a); asm volatile("s_waitcnt lgkmcnt(0)" ::: "memory");              \
                     for (int d_ = 0; d_ < 4; ++d_) for (int r = 0; r < 16; ++r) o[d_][r] *= al_l[crow(r, hi)]; } } while (0)
#define KBASE(t) ((j_lo + (t)) * KVBLK)
#define ACT(t) (KBASE(t) <= qlo + QBLK - 1 && KBASE(t) + KVBLK - 1 >= qlo - W + 1)
#define MASKT(P0_, P1_, t) do { const int kb_ = KBASE(t); if ((!SK || ACT(t)) && (kb_ + KVBLK - 1 > qlo || kb_ <= qlo + QBLK - 1 - W)) mask_tile(P0_, P1_, qm - kb_, (unsigned)W); } while (0)
    constexpr int NQL = F32 ? 16 : 8;
    constexpr bool SK = WSKIP && !F32;
#define SEAM_K0() do { VMWN(NQL); if constexpr (F32) { SWRITE_KF(0); SBAR(); SLOAD_F((const float*)nxt.V, kbn, nxt.rs); } else { SWRITE_HK(0); } SBAR(); } while (0)
    f32x16 pA0, pA1, pB0, pB1; float mnA, mnB, alA, alB; bf16x8 pa0, pa1, pa2, pa3;
    if constexpr (F32) { VMW(); SWRITE_VF(0); SBAR(); } else { SWRITE_HV(0); SBAR(); }
    if (NT > 1) { if constexpr (F32) SLOAD_F((const float*)Kh, KBASE(1), cur.rs); else SLOAD_H(Kh, Vh, KBASE(1), cur.rs); }
    SBAR(); qkt<0, SK>(pA0, pA1, K_lds, r32, hi, S.qr, ACT(0));
    if constexpr (F32) { if (NT > 1) { VMW(); SWRITE_KF(1); SBAR(); SLOAD_F((const float*)Vh, KBASE(1), cur.rs); } }
    MASKT(pA0, pA1, 0); partialSM(pA0, pA1, m_reg, mnA, alA);
    if (NT > 1) { VMW(); if constexpr (F32) { SWRITE_VF(1); SBAR(); if (NT > 2) SLOAD_F((const float*)Kh, KBASE(2), cur.rs); } else SWRITE_H(1); }
    __syncthreads();
#define HALF_STEP(PX0, PX1, mnX, alX, PY0, PY1, alY, t, KB, VB, SB) do {                                                      \
        SBAR(); qkt<KB, SK>(PX0, PX1, K_lds, r32, hi, S.qr, ACT(t));                                             \
        finishSM(PY0, PY1, alY, l_reg, pa0, pa1, pa2, pa3); SBAR();                                                           \
        if ((t) + 1 < NT) { if constexpr (F32) { VMW(); SWRITE_KF(SB); SBAR(); SLOAD_F((const float*)Vh, KBASE((t) + 1), cur.rs); }  \
                            else { SLOAD_H(Kh, Vh, KBASE((t) + 1), cur.rs); } SBAR(); }                                               \
        pv_tile<VB, SK>(o, vb0, pa0, pa1, pa2, pa3, ACT((t) - 1)); MASKT(PX0, PX1, (t)); partialSM(PX0, PX1, m_reg, mnX, alX);                                        \
        __syncthreads();                                                                                                      \
        if ((t) + 1 < NT) { VMW(); if constexpr (F32) { SWRITE_VF(SB); SBAR(); if ((t) + 2 < NT) SLOAD_F((const float*)Kh, KBASE((t) + 2), cur.rs); } \
                            else { SWRITE_H(SB); } }                                                                          \
        RESC(alX); __syncthreads(); } while (0)
    for (int t = 1; t + 1 < NT; t += 2) {
        HALF_STEP(pB0, pB1, mnB, alB, pA0, pA1, alA, t, 1, 0, 0);
        HALF_STEP(pA0, pA1, mnA, alA, pB0, pB1, alB, t + 1, 0, 1, 1);
    }
    const bool even = (NT & 1) == 0;
    if (even) { SBAR(); qkt<1, SK>(pB0, pB1, K_lds, r32, hi, S.qr, ACT(NT - 1)); SBAR(); }
#define QROW(e) (nxt.Q + (size_t)(wid * QBLK + r32) * nxt.rs + ((e) >> 1) * 16 + hi * 8 + ((e) & 1) * 4)
    if constexpr (F32) { SLOAD_F((const float*)nxt.K, kbn, nxt.rs); SBAR();
#pragma unroll
        for (int e = 0; e < 8; ++e) S.tq[e] = *(const f32x4*)QROW(e); }
    else { SLOAD_H(nxt.K, nxt.V, kbn, nxt.rs); SBAR();
#pragma unroll
        for (int d0 = 0; d0 < 8; ++d0) S.qr[d0] = load8<TIn>(nxt.Q + (size_t)(wid * QBLK + r32) * nxt.rs + d0 * 16 + hi * 8); }
    SBAR();
    finishSM(pA0, pA1, alA, l_reg, pa0, pa1, pa2, pa3); SBAR();
    if constexpr (F32) {
#pragma unroll
        for (int e = 8; e < 16; ++e) S.tq[e] = *(const f32x4*)QROW(e); SBAR(); }
#undef QROW
    pv_tile<0, SK>(o, vb0, pa0, pa1, pa2, pa3, ACT(even ? NT - 2 : NT - 1));
    if (even) { MASKT(pB0, pB1, NT - 1); partialSM(pB0, pB1, m_reg, mnB, alB); __syncthreads(); RESC(alB);
        finishSM(pB0, pB1, alB, l_reg, pa0, pa1, pa2, pa3); SBAR(); pv_tile<1, SK>(o, vb0, pa0, pa1, pa2, pa3, ACT(NT - 1)); }
    SBAR(); SEAM_K0();
    if (hi == 0) { li_l[r32] = l_reg; cur.LSE[(size_t)(wid * QBLK + r32) * cur.lrs] = m_reg * SCALE + __logf(l_reg); } asm volatile("s_waitcnt lgkmcnt(0)" ::: "memory");
    float rli[16];
#pragma unroll
    for (int r = 0; r < 16; ++r) rli[r] = __builtin_amdgcn_rcpf(li_l[crow(r, hi)]);
    TOut* Ow = cur.O + (size_t)(wid * QBLK) * cur.ors;
#pragma unroll
    for (int r = 0; r < 16; ++r) { const int orow = crow(r, hi);
#pragma unroll
        for (int d0 = 0; d0 < 4; ++d0) { const float v = o[d0][r] * rli[r];
            if constexpr (same_t<TOut, float>::v) { Ow[(size_t)orow * cur.ors + d0 * 32 + r32] = v; }
            else { const float vn = __shfl_xor(v, 1);
                   if ((r32 & 1) == 0) *(unsigned*)(Ow + (size_t)orow * cur.ors + d0 * 32 + r32) = cvtpk(v, vn); } } }
    if constexpr (F32) {
#pragma unroll
        for (int d0 = 0; d0 < 8; ++d0) S.qr[d0] = pack8(S.tq[2 * d0], S.tq[2 * d0 + 1]); }
    __syncthreads();
#undef RESC
#undef KBASE
#undef ACT
#undef MASKT
#undef SEAM_K0
#undef HALF_STEP
}
#undef ROW
#undef VMW
#undef VMWN
#undef SLOAD_H
#undef SWRITE_HK
#undef SWRITE_HV
#undef SWRITE_H
#undef SLOAD_F
#undef SWRITE_KF
#undef SWRITE_VF


}
#define GAS __attribute__((address_space(1)))
#define LAS __attribute__((address_space(3)))
typedef unsigned short bf16;
typedef unsigned v4u __attribute__((ext_vector_type(4)));
typedef float f32x4 __attribute__((ext_vector_type(4)));
typedef short bf16x8 __attribute__((ext_vector_type(8)));
typedef GAS unsigned gu32;
typedef GAS unsigned long long gu64;
#define RLX_AGENT __ATOMIC_RELAXED, __HIP_MEMORY_SCOPE_AGENT
#define LDS_WAIT() asm volatile("s_waitcnt lgkmcnt(0)" ::: "memory")
#define VM_WAIT() asm volatile("s_waitcnt vmcnt(0)" ::: "memory")
#define XB_TMO      128
#define XB_XCNT(j)  (256  + 64 * (j))
#define XB_XSUB(j)  (1280 + 64 * (j))
#define XB_XGEN(j)  (2304 + 64 * (j))
#define XB_TOP      3328
#define XB_TOPGEN   3392
#define XCD_BAR_WORDS 3456
#define XB_SPIN_CAP (1u << 18)

__device__ __forceinline__ unsigned xb_ld(unsigned* p)              { return __hip_atomic_load(p, __ATOMIC_RELAXED, __HIP_MEMORY_SCOPE_AGENT); }
__device__ __forceinline__ unsigned xb_add(unsigned* p, unsigned v) { return __hip_atomic_fetch_add(p, v, __ATOMIC_RELAXED, __HIP_MEMORY_SCOPE_AGENT); }
__device__ __forceinline__ unsigned xb_xcc_id() { return (unsigned)__builtin_amdgcn_s_getreg((3 << 11) | 20) & 0xFu; }
#define XB_SPIN(cond, bar) do { unsigned _sp = 0; while (cond) { __builtin_amdgcn_s_sleep(1); \
    if ((++_sp & 255u) == 0u) { if (xb_ld(&(bar)[XB_TMO])) break; if (_sp > XB_SPIN_CAP) { atomicAdd(&(bar)[XB_TMO], 1u); break; } } } } while (0)

struct XcdBarrier {
    unsigned* bar; unsigned x;
    volatile LAS unsigned* st;
};

__device__ __forceinline__ XcdBarrier xcd_barrier_post(unsigned* bar, volatile LAS unsigned* st) {
    XcdBarrier b; b.bar = bar; b.x = xb_xcc_id(); b.st = st;
    if (threadIdx.x == 0) (void)xb_add(&bar[XB_XCNT(b.x)], 1u);
    return b;
}
__device__ __forceinline__ void xcd_barrier_complete(unsigned* bar, unsigned x, unsigned& nloc, unsigned& nx) {
    const unsigned G = gridDim.x * gridDim.y * gridDim.z;
    unsigned sum, cnt, mine, sp = 0u;
    for (;;) {
        sum = 0u; cnt = 0u; mine = 0u;
#pragma unroll
        for (unsigned j = 0; j < 16; ++j) { const unsigned c = xb_ld(&bar[XB_XCNT(j)]); sum += c; cnt += (c > 0u) ? 1u : 0u; mine = (j == x) ? c : mine; }
        if (sum == G) break;
        __builtin_amdgcn_s_sleep(1);
        if ((++sp & 255u) == 0u) { if (xb_ld(&bar[XB_TMO])) break; if (sp > XB_SPIN_CAP) { atomicAdd(&bar[XB_TMO], 1u); break; } }
    }
    nloc = mine > 0u ? mine : 1u; nx = cnt > 0u ? cnt : 1u;
}

__device__ __forceinline__ void xcd_barrier(const XcdBarrier& b) {
    asm volatile("s_waitcnt vmcnt(0)" ::: "memory");
    __syncthreads();
    if (threadIdx.x == 0) {
        unsigned* bar = b.bar;
        __builtin_amdgcn_s_waitcnt(0);
        unsigned nloc = b.st[0], nx = b.st[1];
        if (nloc == 0u) { xcd_barrier_complete(bar, b.x, nloc, nx); b.st[0] = nloc; b.st[1] = nx; }
        const unsigned old = xb_add(&bar[XB_XSUB(b.x)], 1u);
        const unsigned gen = old / nloc;
        if (old + 1u == (gen + 1u) * nloc) {
            __builtin_amdgcn_fence(__ATOMIC_RELEASE, "agent");
            asm volatile("s_waitcnt vmcnt(0)" ::: "memory");
            const unsigned og = xb_add(&bar[XB_TOP], 1u);
            const unsigned tg = og / nx;
            if (og + 1u == (tg + 1u) * nx) xb_add(&bar[XB_TOPGEN], 1u);
            else XB_SPIN(xb_ld(&bar[XB_TOPGEN]) == tg, bar);
            __builtin_amdgcn_fence(__ATOMIC_ACQUIRE, "agent");
            xb_add(&bar[XB_XGEN(b.x)], 1u);
            asm volatile("s_waitcnt vmcnt(0)" ::: "memory");
        } else {
            XB_SPIN(xb_ld(&bar[XB_XGEN(b.x)]) == gen, bar);
            __builtin_amdgcn_fence(__ATOMIC_ACQUIRE, "agent");
            asm volatile("s_waitcnt vmcnt(0)" ::: "memory");
        }
    }
    __syncthreads();
}

constexpr int SEQ = 8192, DM = 4096, HD = 128, DFF = 16384, PLE = 256;
constexpr int NIN = 25632, NPROJ = 25856;
constexpr int PROJ_LD = 16640;
constexpr int C_QKVB = 0, C_BA = 6144, C_ZB = 6400, C_GA = 8448, C_GB = 12544, C_QA = 16640, C_KA = 19712, C_VA = 22784;
constexpr int NPA = 8192, NPB1 = 12288, NPB2 = NPROJ - NPA - NPB1;
static_assert(SEQ == (1 << pg8::EP_LSEQ) && C_QA == 256 * pg8::EP_ATT_TILE0 && C_QA == PROJ_LD && C_KA == C_QA + 3072 && C_VA == C_KA + 3072 && NPROJ == C_VA + 3072, "attention tile map");
static_assert(NPB2 == 5376, "parts");
constexpr int DNH = 16, DNW = 2048, ATW = 1024;
constexpr float EPS = 1e-6f;
constexpr int NWAVES = 8;
constexpr int PADK = 0;
#define LDP(K_) ((K_) + PADK)
constexpr int NCH = SEQ / 64;
constexpr int DN_LDS_PER_WAVE = 17920, ABLK_BYTES = 57344;
typedef short v4i16_t __attribute__((ext_vector_type(4)));
#define DN_SWZ(row) ((((row) & 7) ^ ((((row) >> 3) & 1) << 2)))

constexpr size_t MiB = 1u << 20;
constexpr size_t WS_CTL = 0, CTL_ZERO_BYTES = 1 * MiB;
constexpr size_t WS_WIN = 2 * MiB, WS_WAU = 208 * MiB, WS_WDU = 217 * MiB, WS_WOUT = 234 * MiB, WS_WUP = 267 * MiB, WS_WDN = 397 * MiB, WS_WG = 526 * MiB, WS_WPP = 559 * MiB;
constexpr size_t WS_H = 562 * MiB, WS_PB = 627 * MiB, WS_BA = 632 * MiB, WS_BETA = 633 * MiB, WS_GC = 633 * MiB + 512 * 1024, WS_EGL = 634 * MiB;
constexpr size_t WS_PROJ = 636 * MiB, WS_HID = 636 * MiB, WS_PP = 894 * MiB, WS_AQ = 896 * MiB;
constexpr size_t WS_OA = 1040 * MiB, WS_OB = 1057 * MiB, WS_OG = 1090 * MiB, WS_LSE = 1186 * MiB;
constexpr size_t WS_KF = 1187 * MiB, WS_QF = 1219 * MiB, WS_VBT = 1251 * MiB, WS_KBGT = 1283 * MiB, WS_ABLK = 1315 * MiB, WS_U = 1427 * MiB, WS_O = 1491 * MiB;
constexpr size_t WS_T1 = 1187 * MiB, WS_MERGED = 1315 * MiB, WS_X1 = 1380 * MiB;
constexpr size_t WS_SSQ1 = 1556 * MiB, WS_SSQ2 = 1558 * MiB, WS_SSQP = 1560 * MiB, WS_RSTD = 1562 * MiB;
constexpr size_t WS_END = 1563 * MiB;
constexpr int CW_BAR = 4096;

constexpr int RING_OFF = 0, RING_BYTES = 131072;
constexpr int LDSCTL_OFF = 143360, MISC_OFF = LDSCTL_OFF + 320;
constexpr int LDS_BYTES = 147456;

__device__ __forceinline__ unsigned f2bf(float f) { unsigned u = __builtin_bit_cast(unsigned, f); return (u + 0x7fffu + ((u >> 16) & 1u)) >> 16; }
__device__ __forceinline__ unsigned pk2(float lo, float hi) { return f2bf(lo) | (f2bf(hi) << 16); }
__device__ __forceinline__ float bf2f(unsigned short b) { return __uint_as_float(((unsigned)b) << 16); }
__device__ __forceinline__ float wave_sum(float v) {
#pragma unroll
    for (int o = 1; o < 64; o <<= 1) v += __shfl_xor(v, o);
    return v;
}
__device__ __forceinline__ int static_pm0(int M, int N, int c) {
    const int nM = M / pg8::BM, nN = N / pg8::BM, nwg = nM * nN, q = nwg / pg8::NXCD, r = nwg % pg8::NXCD, xcd = c % pg8::NXCD, off = c / pg8::NXCD;
    const int wgid = (xcd < r ? xcd * (q + 1) : r * (q + 1) + (xcd - r) * q) + off, nig = pg8::WGM * nN, fm = (wgid / nig) * pg8::WGM, gsz = (nM - fm) < pg8::WGM ? (nM - fm) : pg8::WGM;
    return fm + ((wgid % nig) % gsz);
}
__device__ __forceinline__ void panel_rstd(const float* __restrict__ ssq, float* __restrict__ rstd, int pm, int tid) {
    const int row = pm * 256 + (tid >> 1); const f32x4* p = (const f32x4*)(ssq + (size_t)row * 64 + (tid & 1) * 32);
    f32x4 a = p[0];
#pragma unroll
    for (int j = 1; j < 8; ++j) a += p[j];
    float s = (a[0] + a[1]) + (a[2] + a[3]); s += __shfl_xor(s, 1);
    if (!(tid & 1)) rstd[row] = 1.0f / sqrtf(s * (1.f / DM) + EPS);
}
__device__ __forceinline__ float wave_max(float v) {
#pragma unroll
    for (int o = 1; o < 64; o <<= 1) v = fmaxf(v, __shfl_xor(v, o));
    return v;
}

__device__ __forceinline__ void tile_load(f32x4 (&v)[8], const float* W, int N, int k0, int n0, int lane) {
    const int kr = lane >> 3, nc = (lane & 7) * 4;
#pragma unroll
    for (int i = 0; i < 8; ++i) v[i] = __builtin_nontemporal_load((const GAS f32x4*)(W + (size_t)(k0 + 8 * i + kr) * N + n0 + nc));
}
template <bool NT = true> __device__ __forceinline__ void tile_store(const f32x4 (&v)[8], bf16* WT, int K, int k0, int drow0, LAS float* scr, int lane, int kdoff) {
    const int kr = lane >> 3, nc = (lane & 7) * 4;
#pragma unroll
    for (int i = 0; i < 8; ++i) { LAS float* d = scr + (8 * i + kr) * 33 + nc; d[0] = v[i].x; d[1] = v[i].y; d[2] = v[i].z; d[3] = v[i].w; }
    LDS_WAIT(); asm volatile("" ::: "memory");
    const int c = lane & 7;
#pragma unroll
    for (int j = 0; j < 4; ++j) { const int n = (lane >> 3) + 8 * j; const LAS float* s = scr + (8 * c) * 33 + n;
        v4u o; o.x = pk2(s[0 * 33], s[1 * 33]); o.y = pk2(s[2 * 33], s[3 * 33]); o.z = pk2(s[4 * 33], s[5 * 33]); o.w = pk2(s[6 * 33], s[7 * 33]);
        GAS v4u* dp_ = (GAS v4u*)(WT + kt_off((size_t)(drow0 + n), kdoff + k0 + 8 * c, K)); if constexpr (NT) __builtin_nontemporal_store(o, dp_); else *dp_ = o; }
    LDS_WAIT(); asm volatile("" ::: "memory");
}
__device__ __forceinline__ void tile_gain(f32x4 (&v)[8], const float* gk, int k0, int lane) {
#pragma unroll
    for (int i = 0; i < 8; ++i) v[i] = v[i] * gk[k0 + 8 * i + (lane >> 3)];
}
__device__ __forceinline__ void transpose_tile(const float* W, int N, bf16* WT, int K, int k0, int n0, int drow0, LAS float* scr, int lane, int kdoff = 0, const float* gk = nullptr) {
    f32x4 v[8]; tile_load(v, W, N, k0, n0, lane); if (gk) tile_gain(v, gk, k0, lane); tile_store(v, WT, K, k0, drow0, scr, lane, kdoff);
}
__device__ __forceinline__ int win_d0(int n0) { return n0 < 9216 ? C_QA + n0 : (n0 < 15360 ? C_QKVB + n0 - 9216 : (n0 < 17408 ? C_ZB + n0 - 15360 : (n0 < 17440 ? C_BA + n0 - 17408 : (n0 < 21536 ? C_GA + n0 - 17440 : C_GB + n0 - 21536)))); }
__device__ __forceinline__ int win_cls(int it) { const int d0 = win_d0(32 * (it % (NIN / 32))); return d0 < NPA ? 1 : (d0 < NPA + NPB1 ? 2 : 3); }
__device__ __forceinline__ void norm_row_bf16(const float* xrow, const float* g, bf16* obase, int orow, int lane) {
    const GAS f32x4* xr = (const GAS f32x4*)xrow + lane; const GAS f32x4* gr = (const GAS f32x4*)g + lane;
    f32x4 v[16]; float s = 0.f;
#pragma unroll
    for (int j = 0; j < 16; ++j) { v[j] = __builtin_nontemporal_load(xr + 64 * j); s += (v[j].x * v[j].x + v[j].y * v[j].y) + (v[j].z * v[j].z + v[j].w * v[j].w); }
    const float rstd = 1.0f / sqrtf(wave_sum(s) * (1.f / DM) + EPS);
#pragma unroll
    for (int j = 0; j < 16; ++j) { const f32x4 gg = gr[64 * j]; const f32x4 y = v[j] * rstd * gg;
        *(GAS unsigned long long*)(obase + kt_off((size_t)orow, 256 * j + 4 * lane, DM)) = (unsigned long long)pk2(y.x, y.y) | ((unsigned long long)pk2(y.z, y.w) << 32); }
}
__device__ __forceinline__ void norm_row_b2f(const bf16* xrow, const float* g, float* orow, int lane) {
    const GAS v4u* xr = (const GAS v4u*)xrow + lane; const GAS f32x4* gr = (const GAS f32x4*)g + 2 * lane;
    f32x4 v[8][2]; float s = 0.f;
#pragma unroll
    for (int j = 0; j < 8; ++j) { pg8::unpack8(xr[64 * j], v[j][0], v[j][1]); s += pg8::dot4(v[j][0]) + pg8::dot4(v[j][1]); }
    const float rstd = 1.0f / sqrtf(wave_sum(s) * (1.f / DM) + EPS);
    GAS f32x4* o = (GAS f32x4*)orow + 2 * lane;
#pragma unroll
    for (int j = 0; j < 8; ++j) { o[128 * j] = v[j][0] * rstd * gr[128 * j]; o[128 * j + 1] = v[j][1] * rstd * gr[128 * j + 1]; }
}
__device__ __forceinline__ void norm_row_f32(const float* xrow, const float* g, float* orow, int lane) {
    const GAS f32x4* xr = (const GAS f32x4*)xrow + lane; const GAS f32x4* gr = (const GAS f32x4*)g + lane;
    f32x4 v[16]; float s = 0.f;
#pragma unroll
    for (int j = 0; j < 16; ++j) { v[j] = xr[64 * j]; s += (v[j].x * v[j].x + v[j].y * v[j].y) + (v[j].z * v[j].z + v[j].w * v[j].w); }
    const float rstd = 1.0f / sqrtf(wave_sum(s) * (1.f / DM) + EPS);
    GAS f32x4* o = (GAS f32x4*)orow + lane;
#pragma unroll
    for (int j = 0; j < 16; ++j) { const f32x4 gg = gr[64 * j]; o[64 * j] = v[j] * rstd * gg; }
}


#ifndef CV_P3_TILES
#define CV_P3_TILES 0
#endif
constexpr int CV_IN = (DM / 64) * (NIN / 32), CV_AU = (ATW / 64) * (DM / 32), CV_DU = (DNW / 64) * (DM / 32), CV_OUT = (DM / 64) * (DM / 32), CV_UP = (DM / 64) * (DFF / 32), CV_DN = (DFF / 64) * (DM / 32),
              CV_G = CV_OUT, CV_PP = (PLE / 64) * (DM / 32), CV_ALL = CV_IN + CV_AU + CV_DU + CV_OUT + CV_UP + CV_DN + CV_G + CV_PP;
constexpr int CV_TAIL = CV_IN + 28000, CV_P3 = CV_ALL - CV_P3_TILES;
#define CONV_ITEMS(FIRST, LAST, WIDX, NW) CONV_ITEMS_C(FIRST, LAST, WIDX, NW, 0)
#define CONV_ITEMS_C(FIRST, LAST, WIDX, NW, CLS) do { LAS float* scr_ = (LAS float*)(L + RING_OFF + wave * 16384); \
    for (int it_ = (FIRST) + (WIDX); it_ < (LAST); it_ += (NW)) { int r = it_; const int nb4 = DM / 32; \
        if (r < CV_IN) { const int nblk = NIN / 32, kb = r / nblk, nb = r % nblk, n0 = 32 * nb; const int d0 = n0 < 9216 ? C_QA + n0 : (n0 < 15360 ? C_QKVB + n0 - 9216 : (n0 < 17408 ? C_ZB + n0 - 15360 : (n0 < 17440 ? C_BA + n0 - 17408 : (n0 < 21536 ? C_GA + n0 - 17440 : C_GB + n0 - 21536)))); \
            const int cls_ = d0 < NPA ? 1 : (d0 < NPA + NPB1 ? 2 : 3);     \
            if ((CLS) == 0 || (CLS) == cls_) transpose_tile(w_in, NIN, WIN_T, LDP(DM), 64 * kb, n0, d0, scr_, lane); } \
        else if ((r -= CV_IN) < CV_AU) transpose_tile(w_attn_up, DM, WAU_T, LDP(ATW + DNW), 64 * (r / nb4), 32 * (r % nb4), 32 * (r % nb4), scr_, lane, DNW); \
        else if ((r -= CV_AU) < CV_DU) transpose_tile(w_dn_up, DM, WAU_T, LDP(ATW + DNW), 64 * (r / nb4), 32 * (r % nb4), 32 * (r % nb4), scr_, lane); \
        else if ((r -= CV_DU) < CV_OUT) transpose_tile(w_out, DM, WOUT_T, LDP(DM), 64 * (r / nb4), 32 * (r % nb4), 32 * (r % nb4), scr_, lane); \
        else if ((r -= CV_OUT) < CV_UP) { const int nblk = DFF / 32; transpose_tile(w_mlp_up, DFF, WUP_T, LDP(DM), 64 * (r / nblk), 32 * (r % nblk), 32 * (r % nblk), scr_, lane, 0, norm_mlp); } \
        else if ((r -= CV_UP) < CV_DN) transpose_tile(w_mlp_down, DM, WDN_T, LDP(DFF), 64 * (r / nb4), 32 * (r % nb4), 32 * (r % nb4), scr_, lane); \
        else if ((r -= CV_DN) < CV_G) transpose_tile(w_ple_gate, DM, WG_T, LDP(DM), 64 * (r / nb4), 32 * (r % nb4), 32 * (r % nb4), scr_, lane, 0, norm_ple); \
        else { r -= CV_G; transpose_tile(w_ple_proj, DM, WPP_T, LDP(PLE), 64 * (r / nb4), 32 * (r % nb4), 32 * (r % nb4), scr_, lane); } } } while (0)

#define CONV_WIN_PIPE(CLS, WIDX, NW, SCR) do { LAS float* scr_ = (LAS float*)(SCR); const int nblk_ = NIN / 32; \
    int it_ = (WIDX); while (it_ < CV_IN && win_cls(it_) != (CLS)) it_ += (NW); \
    if (it_ < CV_IN) { f32x4 va_[8]; tile_load(va_, w_in, NIN, 64 * (it_ / nblk_), 32 * (it_ % nblk_), lane); \
        for (;;) { int nx_ = it_ + (NW); while (nx_ < CV_IN && win_cls(nx_) != (CLS)) nx_ += (NW); const bool more_ = nx_ < CV_IN; f32x4 vb_[8]; \
            if (more_) tile_load(vb_, w_in, NIN, 64 * (nx_ / nblk_), 32 * (nx_ % nblk_), lane); \
            tile_store<false>(va_, WIN_T, LDP(DM), 64 * (it_ / nblk_), win_d0(32 * (it_ % nblk_)), scr_, lane, 0); \
            if (!more_) break; \
            _Pragma("unroll") for (int i_ = 0; i_ < 8; ++i_) va_[i_] = vb_[i_]; it_ = nx_; } } } while (0)

struct CvT { const float* W; bf16* WT; const float* gk; int N, K, k0, n0, d0, kd; };
#define CV_DESC(R_, T_) do { int r = (R_); const int nb4 = DM / 32; T_.gk = nullptr; \
        if (r < CV_IN) { const int nblk = NIN / 32; T_.W = w_in; T_.N = NIN; T_.WT = WIN_T; T_.K = DM; T_.k0 = 64 * (r / nblk); T_.n0 = 32 * (r % nblk); T_.d0 = win_d0(T_.n0); T_.kd = 0; } \
        else if ((r -= CV_IN) < CV_AU) { T_.W = w_attn_up; T_.N = DM; T_.WT = WAU_T; T_.K = ATW + DNW; T_.k0 = 64 * (r / nb4); T_.n0 = 32 * (r % nb4); T_.d0 = T_.n0; T_.kd = DNW; } \
        else if ((r -= CV_AU) < CV_DU) { T_.W = w_dn_up; T_.N = DM; T_.WT = WAU_T; T_.K = ATW + DNW; T_.k0 = 64 * (r / nb4); T_.n0 = 32 * (r % nb4); T_.d0 = T_.n0; T_.kd = 0; } \
        else if ((r -= CV_DU) < CV_OUT) { T_.W = w_out; T_.N = DM; T_.WT = WOUT_T; T_.K = DM; T_.k0 = 64 * (r / nb4); T_.n0 = 32 * (r % nb4); T_.d0 = T_.n0; T_.kd = 0; } \
        else if ((r -= CV_OUT) < CV_UP) { const int nblk = DFF / 32; T_.W = w_mlp_up; T_.gk = norm_mlp; T_.N = DFF; T_.WT = WUP_T; T_.K = DM; T_.k0 = 64 * (r / nblk); T_.n0 = 32 * (r % nblk); T_.d0 = T_.n0; T_.kd = 0; } \
        else if ((r -= CV_UP) < CV_DN) { T_.W = w_mlp_down; T_.N = DM; T_.WT = WDN_T; T_.K = DFF; T_.k0 = 64 * (r / nb4); T_.n0 = 32 * (r % nb4); T_.d0 = T_.n0; T_.kd = 0; } \
        else if ((r -= CV_DN) < CV_G) { T_.W = w_ple_gate; T_.gk = norm_ple; T_.N = DM; T_.WT = WG_T; T_.K = DM; T_.k0 = 64 * (r / nb4); T_.n0 = 32 * (r % nb4); T_.d0 = T_.n0; T_.kd = 0; } \
        else { r -= CV_G; T_.W = w_ple_proj; T_.N = DM; T_.WT = WPP_T; T_.K = PLE; T_.k0 = 64 * (r / nb4); T_.n0 = 32 * (r % nb4); T_.d0 = T_.n0; T_.kd = 0; } } while (0)
#define CONV_ITEMS_PIPE(FIRST, LAST, WIDX, NW) do { LAS float* scr_ = (LAS float*)(L + RING_OFF + wave * 16384); int it_ = (FIRST) + (WIDX); \
    if (it_ < (LAST)) { CvT ta_; CV_DESC(it_, ta_); f32x4 va_[8]; tile_load(va_, ta_.W, ta_.N, ta_.k0, ta_.n0, lane); \
        for (;;) { const int nx_ = it_ + (NW); const bool more_ = nx_ < (LAST); CvT tb_ = ta_; f32x4 vb_[8]; \
            if (more_) { CV_DESC(nx_, tb_); tile_load(vb_, tb_.W, tb_.N, tb_.k0, tb_.n0, lane); } \
            if (ta_.gk) tile_gain(va_, ta_.gk, ta_.k0, lane); tile_store(va_, ta_.WT, ta_.K, ta_.k0, ta_.d0, scr_, lane, ta_.kd); \
            if (!more_) break; \
            _Pragma("unroll") for (int i_ = 0; i_ < 8; ++i_) va_[i_] = vb_[i_]; ta_ = tb_; it_ = nx_; } } } while (0)

constexpr int ATT_ITEMS = 768;
constexpr int SC_PF = 5;
constexpr int SC_SPLIT = 4, SC_NT = 8 / SC_SPLIT, SCAN_WGS = DNH * SC_SPLIT;
__device__ __forceinline__ void att_ref(swa::BlockRef<swa::bf16, swa::bf16>& b, int& d, int item, const bf16* AQ, bf16* OG, float* LSEB) {
    const int g = item >> 8, rem = item & 255, h = rem & 7, x = rem >> 3;
    d = g == 0 ? 1 : (g == 1 ? 4 : 16); const int nqb = 32 / d, r = x / nqb, qb = x % nqb; const size_t t0 = (size_t)r + (size_t)d * qb * 256;
    const size_t Ls = (size_t)(SEQ / d), hs = (size_t)SEQ * HD;
    b.Q = AQ + (size_t)((0 * 3 + g) * 8 + h) * hs + ((size_t)r * Ls + (size_t)qb * 256) * HD; b.K = AQ + (size_t)((1 * 3 + g) * 8 + h) * hs + (size_t)r * Ls * HD; b.V = AQ + (size_t)((2 * 3 + g) * 8 + h) * hs + (size_t)r * Ls * HD;
    b.O = OG + (size_t)g * SEQ * ATW + t0 * ATW + h * HD; b.LSE = LSEB + (size_t)g * SEQ * 8 + t0 * 8 + h;
    b.P0 = qb * 256; b.rs = HD; b.ors = d * ATW; b.lrs = d * 8;
}

struct Args { const float* in[19]; float* out; unsigned char* ws; int ph_lo, ph_hi, li, pad; };
constexpr int N_PHASES = 17;

__global__ void __launch_bounds__(NWAVES * 64, 2) mk_fwd(Args args) {
    extern __shared__ __attribute__((aligned(16))) unsigned char lds[];
    LAS unsigned char* L = (LAS unsigned char*)lds;
    volatile LAS unsigned* MISC = (volatile LAS unsigned*)(L + MISC_OFF);
    int tid = otid(), lane = tid & 63; const int wave = __builtin_amdgcn_readfirstlane(tid >> 6);
    const int G = gridDim.x; const int bx = blockIdx.x; const int vcu = (G % 8 == 0) ? (bx % 8) * (G / 8) + bx / 8 : bx;
    const int gw = vcu * NWAVES + wave, NGW = G * NWAVES;
    unsigned char* ws = args.ws;
    gu32* ctl = (gu32*)(ws + WS_CTL);
    const float* x = args.in[0]; const float* p_in = args.in[1]; const float* w_in = args.in[2]; const float* conv_w = args.in[3]; const float* dn_a_log = args.in[4]; const float* dn_dt_bias = args.in[5];
    const float* dn_norm = args.in[6]; const float* w_attn_up = args.in[7]; const float* w_dn_up = args.in[8]; const float* w_out = args.in[9]; const float* w_mlp_up = args.in[10]; const float* w_mlp_down = args.in[11];
    const float* w_ple_gate = args.in[12]; const float* w_ple_proj = args.in[13]; const float* norm_mix = args.in[14]; const float* norm_mlp = args.in[15]; const float* norm_ple = args.in[16];
    const float* ple_post_norm = args.in[17]; const float* final_norm = args.in[18];
    float* out = args.out;
    bf16* WIN_T = (bf16*)(ws + WS_WIN); bf16* WAU_T = (bf16*)(ws + WS_WAU); bf16* WDU_T = (bf16*)(ws + WS_WDU); bf16* WOUT_T = (bf16*)(ws + WS_WOUT); bf16* WUP_T = (bf16*)(ws + WS_WUP);
    bf16* WDN_T = (bf16*)(ws + WS_WDN); bf16* WG_T = (bf16*)(ws + WS_WG); bf16* WPP_T = (bf16*)(ws + WS_WPP);
    bf16* HB = (bf16*)(ws + WS_H); bf16* PB = (bf16*)(ws + WS_PB); float* BA = (float*)(ws + WS_BA); float* BETA = (float*)(ws + WS_BETA); float* GC = (float*)(ws + WS_GC); float* EGL = (float*)(ws + WS_EGL);
    bf16* PROJ = (bf16*)(ws + WS_PROJ); bf16* HID = (bf16*)(ws + WS_HID); bf16* PP = (bf16*)(ws + WS_PP); bf16* AQ = (bf16*)(ws + WS_AQ);
    bf16* OA = (bf16*)(ws + WS_OA); bf16* OB = (bf16*)(ws + WS_OB); bf16* OG = (bf16*)(ws + WS_OG); float* LSEB = (float*)(ws + WS_LSE);
    bf16* KF = (bf16*)(ws + WS_KF); bf16* QF = (bf16*)(ws + WS_QF); bf16* VBT = (bf16*)(ws + WS_VBT); bf16* KBGT = (bf16*)(ws + WS_KBGT); unsigned char* ABLK = ws + WS_ABLK; float* U = (float*)(ws + WS_U); float* OS = (float*)(ws + WS_O);
    float* SSQ1 = (float*)(ws + WS_SSQ1); float* SSQ2 = (float*)(ws + WS_SSQ2); float* SSQP = (float*)(ws + WS_SSQP); float* RSTD1 = (float*)(ws + WS_RSTD); float* RSTD2 = RSTD1 + SEQ; float* RSTDP = RSTD2 + SEQ;
    float* T1 = (float*)(ws + WS_T1); bf16* MERGED = (bf16*)(ws + WS_MERGED); bf16* X1 = (bf16*)(ws + WS_X1); bf16* X2 = (bf16*)(ws + WS_X1 + 64 * MiB);

    for (int u = tid; u < (LDS_BYTES - LDSCTL_OFF) / 4; u += NWAVES * 64) ((LAS unsigned*)(L + LDSCTL_OFF))[u] = 0u;
    __syncthreads();
    XcdBarrier bar = xcd_barrier_post((unsigned*)(ctl + CW_BAR) + args.li * XCD_BAR_WORDS, MISC + 8);
    const int lo = args.ph_lo, hi = args.ph_hi;
#ifndef GEMM_ALIGN
#define GEMM_ALIGN true
#endif
#ifndef GEMM_SP2
#define GEMM_SP2 true
#endif
#ifndef DN_PROBE
#define DN_PROBE 0
#endif
#ifndef SCAN_PROBE_VARIANT
#define SCAN_PROBE_VARIANT 0
#endif
#ifndef REPMASK
#define REPMASK 0u
#endif
#ifndef REPN
#define REPN 1
#endif
#ifndef PHMASK
#define PHMASK 0xffffffffu
#endif
#define IN(k) (((PHMASK >> (k)) & 1u) && lo <= (k) && (k) < hi)
#define SEAM(k) do { if (IN(k) && IN((k) + 1)) xcd_barrier(bar); } while (0)

    _Pragma("unroll") for (int _rep = 0; _rep < 1 + REPN * (int)((REPMASK >> 0) & 1u); ++_rep) { if (_rep) xcd_barrier(bar); tid = otid(); lane = tid & 63;
    if (IN(0)) {
        CONV_WIN_PIPE(1, gw, NGW, L + RING_OFF + wave * 16384);
        { const size_t nz = (size_t)(NPROJ - NIN) * (DM / 8);
          for (size_t i = (size_t)gw * 64 + lane; i < nz; i += (size_t)NGW * 64) *(GAS v4u*)(WIN_T + kt_off((size_t)(C_BA + 32) + i / (DM / 8), (int)(i % (DM / 8)) * 8, DM)) = (v4u){0u, 0u, 0u, 0u}; }
#ifdef DBG_NANFILL
        { GAS v4u* z = (GAS v4u*)(ws + WS_KF); const size_t nz = (size_t)(WS_END - WS_KF) / 16;
          for (size_t i = (size_t)gw * 64 + lane; i < nz; i += (size_t)NGW * 64) z[i] = (v4u){0xffffffffu, 0xffffffffu, 0xffffffffu, 0xffffffffu}; }
#endif
        for (int m = gw; m < SEQ; m += NGW) norm_row_bf16(x + (size_t)m * DM, norm_mix, HB, m, lane);
        { const size_t n8 = (size_t)SEQ * PLE / 8;
          for (size_t i = (size_t)gw * 64 + lane; i < n8; i += (size_t)NGW * 64) { const GAS f32x4* s = (const GAS f32x4*)p_in + 2 * i; const f32x4 a = s[0], b = s[1];
              v4u o; o.x = pk2(a.x, a.y); o.y = pk2(a.z, a.w); o.z = pk2(b.x, b.y); o.w = pk2(b.z, b.w); *(GAS v4u*)(PB + kt_off(i / (PLE / 8), (int)(i % (PLE / 8)) * 8, PLE)) = o; } }
    }
    }
    SEAM(0);

    _Pragma("unroll") for (int _rep = 0; _rep < 1 + REPN * (int)((REPMASK >> 1) & 1u); ++_rep) { if (_rep) xcd_barrier(bar); tid = otid(); lane = tid & 63;
    if (IN(1)) {
        pg8::Gemm g{HB, WIN_T, SEQ, NPA, DM, LDP(DM)}; pg8::StaticOrder S; S.init(SEQ, NPA, G, (int)blockIdx.x);
        pg8::EpiProj E{PROJ, PROJ_LD, BA, C_BA / 256, AQ, 0};
        pg8::gemm_phase<pg8::EpiProj, pg8::StaticOrder, GEMM_ALIGN, GEMM_SP2>(L + RING_OFF, g, S, E);
    }
    }
    SEAM(1);

    _Pragma("unroll") for (int _rep = 0; _rep < 1 + REPN * (int)((REPMASK >> 2) & 1u); ++_rep) { if (_rep) xcd_barrier(bar); tid = otid(); lane = tid & 63;
    if (IN(2)) {
        LAS unsigned char* wl = L + wave * DN_LDS_PER_WAVE;
        LAS float* tb = (LAS float*)(wl + 16384);
        const int tq = lane >> 4, cg = lane & 15, fg = lane >> 4, fc = lane & 15;
        for (int it = gw; it < DNH * NCH; it += NGW) {
            const int h = it / NCH, n = it % NCH; const size_t un = (size_t)h * NCH + n;
            { const int t = 64 * n + lane; const float braw = BA[(size_t)t * 32 + h], araw = BA[(size_t)t * 32 + 16 + h];
              const float xs = araw + dn_dt_bias[h]; const float sp = fmaxf(xs, 0.f) + log1pf(expf(-fabsf(xs)));
              const float beta = pg8::sigm(braw); float gc = -expf(dn_a_log[h]) * sp;
#pragma unroll
              for (int o = 1; o < 64; o <<= 1) { const float y = __shfl_up(gc, o); if (lane >= o) gc += y; }
              const float gl = __shfl(gc, 63), eg = expf(gc);
              tb[lane] = eg; tb[64 + lane] = beta * eg; tb[128 + lane] = expf(gl - gc); tb[192 + lane] = beta;
              BETA[(size_t)h * SEQ + t] = beta; GC[(size_t)h * SEQ + t] = gc; if (lane == 0) EGL[un] = expf(gl); }
            LDS_WAIT(); asm volatile("" ::: "memory");
            bf16* KFu = KF + un * 8192; bf16* QFu = QF + un * 8192; bf16* VBTu = VBT + un * 8192; bf16* KBGTu = KBGT + un * 8192; unsigned char* ABu = ABLK + un * ABLK_BYTES;
#pragma unroll 1
            for (int which = 0; which < 3; ++which) {
                const int ch = which * DNW + h * HD + cg * 8;
                f32x4 w[4][2];
#pragma unroll
                for (int j = 0; j < 4; ++j) { w[j][0] = *(const GAS f32x4*)(conv_w + (size_t)j * 3 * DNW + ch); w[j][1] = *(const GAS f32x4*)(conv_w + (size_t)j * 3 * DNW + ch + 4); }
                const bf16* src = PROJ + C_QKVB + ch;
                v4u xr[19];
#pragma unroll
                for (int j = 0; j < 19; ++j) { const int tt = 64 * n + 16 * tq - 3 + j; xr[j] = (v4u){0u, 0u, 0u, 0u}; if (tt >= 0) xr[j] = *(const GAS v4u*)(src + (size_t)tt * PROJ_LD); }
#pragma unroll
                for (int s = 0; s < 16; ++s) {
                    int tq_o = lane >> 4, cg_o = lane & 15; asm volatile("" : "+v"(tq_o), "+v"(cg_o));
                    const int tq = tq_o, cg = cg_o;
                    const int tl = 16 * tq + s, t = 64 * n + tl;
                    f32x4 y0 = {0.f, 0.f, 0.f, 0.f}, y1 = {0.f, 0.f, 0.f, 0.f};
#pragma unroll
                    for (int j = 0; j < 4; ++j) { f32x4 a, b; pg8::unpack8(xr[s + j], a, b); y0 += a * w[j][0]; y1 += b * w[j][1]; }
                    y0 = y0 * pg8::sigm4(y0); y1 = y1 * pg8::sigm4(y1);
                    if (which < 2) {
                        float ss = (y0.x * y0.x + y0.y * y0.y) + (y0.z * y0.z + y0.w * y0.w) + (y1.x * y1.x + y1.y * y1.y) + (y1.z * y1.z + y1.w * y1.w);
                        ss += __shfl_xor(ss, 1); ss += __shfl_xor(ss, 2); ss += __shfl_xor(ss, 4); ss += __shfl_xor(ss, 8);
                        float r = 1.0f / sqrtf(ss + EPS); if (which == 0) r *= 0.08838834764831845f;
                        y0 = y0 * r; y1 = y1 * r;
                    }
                    *(LAS v4u*)(wl + tl * 256 + ((cg ^ (2 * DN_SWZ(tl))) << 4)) = pg8::pack8(y0, y1);
                }
                LDS_WAIT(); asm volatile("" ::: "memory");
                if (which < 2) {
                    const int sw = 2 * DN_SWZ(fc); bf16* dfr = which == 0 ? QFu : KFu;
#pragma unroll 1
                    for (int rt = 0; rt < 4; ++rt) { const LAS unsigned char* rp = wl + (16 * rt + fc) * 256; const float fq_ = tb[16 * rt + fc];
#pragma unroll
                        for (int s = 0; s < 4; ++s) {
                            *(GAS v4u*)(dfr + ((rt * 4 + s) * 64 + lane) * 8) = *(const LAS v4u*)(rp + (((4 * s + fg) ^ sw) << 4));
                            if (which == 0) {
                                const unsigned long long lo = *(const LAS unsigned long long*)(rp + (((4 * s + (fg >> 1)) ^ sw) << 4) + (fg & 1) * 8), hi = *(const LAS unsigned long long*)(rp + (((4 * s + 2 + (fg >> 1)) ^ sw) << 4) + (fg & 1) * 8);
                                const unsigned l0 = (unsigned)lo, l1 = (unsigned)(lo >> 32), h0 = (unsigned)hi, h1 = (unsigned)(hi >> 32);
                                v4u o; o.x = pg8::cvt_pk_bf16(__uint_as_float(l0 << 16) * fq_, __uint_as_float(l0 & 0xffff0000u) * fq_); o.y = pg8::cvt_pk_bf16(__uint_as_float(l1 << 16) * fq_, __uint_as_float(l1 & 0xffff0000u) * fq_);
                                o.z = pg8::cvt_pk_bf16(__uint_as_float(h0 << 16) * fq_, __uint_as_float(h0 & 0xffff0000u) * fq_); o.w = pg8::cvt_pk_bf16(__uint_as_float(h1 << 16) * fq_, __uint_as_float(h1 & 0xffff0000u) * fq_);
                                *(GAS v4u*)(ABu + (size_t)(16 + rt * 4 + s) * 1024 + lane * 16) = o; }
                        } }
                }
                if (which == 0) { LDS_WAIT(); asm volatile("" ::: "memory"); continue; }
                if (_rep && DN_PROBE == 2) continue;
                LDS_WAIT(); asm volatile("" ::: "memory");
                const int qq = fc >> 2, pp = fc & 3;
#define DN_TRREAD(ROW, CT) __builtin_amdgcn_ds_read_tr16_b64_v4i16((LAS v4i16_t*)(wl + (ROW) * 256 + (((2 * (CT) + (pp >> 1)) ^ (2 * DN_SWZ(ROW))) << 4) + (pp & 1) * 8))
#define DN_SCALE4(V, F) pg8::cvt_pk_bf16(bf2f((unsigned short)(V)[0]) * (F)[0], bf2f((unsigned short)(V)[1]) * (F)[1]), pg8::cvt_pk_bf16(bf2f((unsigned short)(V)[2]) * (F)[2], bf2f((unsigned short)(V)[3]) * (F)[3])
#pragma unroll 1
                for (int s2 = 0; s2 < 2; ++s2) {
                    const LAS float* ft = tb + (which == 1 ? 64 : 192) + 32 * s2 + 8 * fg; const f32x4 f0 = *(const LAS f32x4*)ft, f1 = *(const LAS f32x4*)(ft + 4);
                    bf16* dstn = (which == 1 ? KBGTu : VBTu);
#pragma unroll 2
                    for (int ct = 0; ct < 8; ++ct) {
                        const v4i16_t a = DN_TRREAD(32 * s2 + 8 * fg + qq, ct), b = DN_TRREAD(32 * s2 + 8 * fg + 4 + qq, ct);
                        v4u o = {DN_SCALE4(a, f0), DN_SCALE4(b, f1)};
                        *(GAS v4u*)(dstn + ((ct * 2 + s2) * 64 + lane) * 8) = o;
                    }
                    if (which == 1) {
                        const LAS float* fk = tb + 128 + 32 * s2 + 4 * fg; const f32x4 k0 = *(const LAS f32x4*)fk, k1 = *(const LAS f32x4*)(fk + 16);
#pragma unroll 2
                        for (int kt = 0; kt < 8; ++kt) {
                            const v4i16_t a = DN_TRREAD(32 * s2 + 4 * fg + qq, kt), b = DN_TRREAD(32 * s2 + 16 + 4 * fg + qq, kt);
                            v4u o = {DN_SCALE4(a, k0), DN_SCALE4(b, k1)};
                            *(GAS v4u*)(ABu + (size_t)(32 + kt * 2 + s2) * 1024 + lane * 16) = o;
                        }
                    }
                }
                LDS_WAIT(); asm volatile("" ::: "memory");
            }
        }
    }
    }
#ifdef DN_SEAM_BARRIER
    SEAM(2);
#else
    if (IN(2) && IN(3)) { VM_WAIT(); asm volatile("" ::: "memory"); } else SEAM(2);
#endif

    _Pragma("unroll") for (int _rep = 0; _rep < 1 + REPN * (int)((REPMASK >> 3) & 1u); ++_rep) { if (_rep) xcd_barrier(bar); tid = otid(); lane = tid & 63;
    if (IN(3)) {
        LAS unsigned char* wl = L + wave * DN_LDS_PER_WAVE;
        LAS float* Am = (LAS float*)wl;
        LAS float* tbb = (LAS float*)(wl + 17408);
        const int fg = lane >> 4, fc = lane & 15;
        for (int it = gw; it < DNH * NCH; it += NGW) {
            const int h = it / NCH, n = it % NCH; const size_t un = (size_t)h * NCH + n;
            const bf16* KFu = KF + un * 8192; const bf16* QFu = QF + un * 8192; const bf16* VBTu = VBT + un * 8192; const bf16* KBGTu = KBGT + un * 8192; unsigned char* ABu = ABLK + un * ABLK_BYTES;
            { const int t = 64 * n + lane; tbb[lane] = BETA[(size_t)h * SEQ + t]; tbb[64 + lane] = GC[(size_t)h * SEQ + t]; }
            bf16x8 kf[4][4];
#pragma unroll
            for (int rt = 0; rt < 4; ++rt)
#pragma unroll
                for (int s = 0; s < 4; ++s) kf[rt][s] = *(const GAS bf16x8*)(KFu + ((rt * 4 + s) * 64 + lane) * 8);
            LDS_WAIT(); asm volatile("" ::: "memory");
#pragma unroll
            for (int mt = 0; mt < 4; ++mt) {
                const f32x4 bi = *(const LAS f32x4*)(tbb + 16 * mt + 4 * fg), gi = *(const LAS f32x4*)(tbb + 64 + 16 * mt + 4 * fg);
#pragma unroll
                for (int nt = 0; nt <= mt; ++nt) {
                    f32x4 acc = {0.f, 0.f, 0.f, 0.f};
#pragma unroll
                    for (int s = 0; s < 4; ++s) acc = __builtin_amdgcn_mfma_f32_16x16x32_bf16(kf[mt][s], kf[nt][s], acc, 0, 0, 0);
                    const float gj = tbb[64 + 16 * nt + fc]; const int j = 16 * nt + fc;
#pragma unroll
                    for (int r = 0; r < 4; ++r) { const int i = 16 * mt + 4 * fg + r; const float v = bi[r] * acc[r] * __expf(fminf(gi[r] - gj, 0.f)); Am[i * 68 + j] = (i > j) ? v : 0.f; }
                }
            }
#pragma unroll 2
            for (int nt = 0; nt < 4; ++nt) {
                bf16x8 qf[4];
#pragma unroll
                for (int s = 0; s < 4; ++s) qf[s] = *(const GAS bf16x8*)(QFu + ((nt * 4 + s) * 64 + lane) * 8);
                const float gi = tbb[64 + 16 * nt + fc]; const int i = 16 * nt + fc;
#pragma unroll
                for (int s2 = 0; s2 < 2; ++s2) {
                    v4u o;
#pragma unroll
                    for (int hh = 0; hh < 2; ++hh) {
                        const int mt = 2 * s2 + hh; f32x4 acc = {0.f, 0.f, 0.f, 0.f};
#pragma unroll
                        for (int s = 0; s < 4; ++s) acc = __builtin_amdgcn_mfma_f32_16x16x32_bf16(kf[mt][s], qf[s], acc, 0, 0, 0);
                        const f32x4 gj = *(const LAS f32x4*)(tbb + 64 + 16 * mt + 4 * fg); float v[4];
#pragma unroll
                        for (int r = 0; r < 4; ++r) { const int j = 16 * mt + 4 * fg + r; const float e = acc[r] * __expf(fminf(gi - gj[r], 0.f)); v[r] = (i >= j) ? e : 0.f; }
                        if (hh == 0) { o.x = pg8::cvt_pk_bf16(v[0], v[1]); o.y = pg8::cvt_pk_bf16(v[2], v[3]); } else { o.z = pg8::cvt_pk_bf16(v[0], v[1]); o.w = pg8::cvt_pk_bf16(v[2], v[3]); }
                    }
                    *(GAS v4u*)(ABu + (size_t)(48 + nt * 2 + s2) * 1024 + lane * 16) = o;
                }
            }
            LDS_WAIT(); asm volatile("" ::: "memory");
            float Tc[64];
#pragma unroll
            for (int i = 0; i < 64; ++i) {
                float a = (lane == i) ? 1.f : 0.f;
                if (!(_rep && DN_PROBE == 3))
#pragma unroll
                for (int j0 = 0; j0 < i; j0 += 4) { const f32x4 av = *(const LAS f32x4*)(Am + i * 68 + j0);
                    a -= av.x * Tc[j0]; if (j0 + 1 < i) a -= av.y * Tc[j0 + 1]; if (j0 + 2 < i) a -= av.z * Tc[j0 + 2]; if (j0 + 3 < i) a -= av.w * Tc[j0 + 3]; }
                Tc[i] = a;
                if ((i & 7) == 7) asm volatile("" ::: "memory");
            }
            LDS_WAIT(); asm volatile("" ::: "memory");
#pragma unroll
            for (int i = 0; i < 64; ++i) *(LAS unsigned short*)(wl + i * 144 + lane * 2) = (unsigned short)f2bf(Tc[i]);
            LDS_WAIT(); asm volatile("" ::: "memory");
            bf16x8 vbt[8][2], kbt[8][2];
#pragma unroll
            for (int q = 0; q < 8; ++q)
#pragma unroll
                for (int s2 = 0; s2 < 2; ++s2) vbt[q][s2] = *(const GAS bf16x8*)(VBTu + ((q * 2 + s2) * 64 + lane) * 8);
            bf16x8 tf[4][2];
#pragma unroll
            for (int rt = 0; rt < 4; ++rt)
#pragma unroll
                for (int s2 = 0; s2 < 2; ++s2) tf[rt][s2] = *(const LAS bf16x8*)(wl + (16 * rt + fc) * 144 + (32 * s2 + 8 * fg) * 2);
            if (!(_rep && DN_PROBE == 4)) {
            float* Uu = U + un * 8192;
#pragma unroll
            for (int cw = 0; cw < 8; ++cw) {
                const bf16x8 v0 = vbt[cw][0], v1 = vbt[cw][1];
#pragma unroll
                for (int mt = 0; mt < 4; ++mt) { f32x4 acc = {0.f, 0.f, 0.f, 0.f};
                    acc = __builtin_amdgcn_mfma_f32_16x16x32_bf16(tf[mt][0], v0, acc, 0, 0, 0); acc = __builtin_amdgcn_mfma_f32_16x16x32_bf16(tf[mt][1], v1, acc, 0, 0, 0);
                    *(GAS f32x4*)(Uu + ((mt * 8 + cw) * 64 + lane) * 4) = acc; }
            }
            asm volatile("" ::: "memory");
#pragma unroll
            for (int q = 0; q < 8; ++q)
#pragma unroll
                for (int s2 = 0; s2 < 2; ++s2) kbt[q][s2] = *(const GAS bf16x8*)(KBGTu + ((q * 2 + s2) * 64 + lane) * 8);
#pragma unroll
            for (int s = 0; s < 4; ++s) {
                f32x4 acc[4][2];
#pragma unroll
                for (int hh = 0; hh < 2; ++hh) { const int dt = 2 * s + hh;
                    const bf16x8 k0 = kbt[dt][0], k1 = kbt[dt][1];
#pragma unroll
                    for (int nt = 0; nt < 4; ++nt) { f32x4 a = {0.f, 0.f, 0.f, 0.f};
                        a = __builtin_amdgcn_mfma_f32_16x16x32_bf16(k0, tf[nt][0], a, 0, 0, 0); a = __builtin_amdgcn_mfma_f32_16x16x32_bf16(k1, tf[nt][1], a, 0, 0, 0); acc[nt][hh] = a; } }
#pragma unroll
                for (int nt = 0; nt < 4; ++nt) *(GAS v4u*)(ABu + (size_t)(nt * 4 + s) * 1024 + lane * 16) = pg8::pack8(-acc[nt][0], -acc[nt][1]);
            }
            }
            LDS_WAIT(); asm volatile("" ::: "memory");
        }
        if (_rep == 0) CONV_WIN_PIPE(2, gw, NGW, L + wave * DN_LDS_PER_WAVE);
    }
    }
    SEAM(3);

    _Pragma("unroll") for (int _rep = 0; _rep < 1 + REPN * (int)((REPMASK >> 4) & 1u); ++_rep) { if (_rep) xcd_barrier(bar); tid = otid(); lane = tid & 63;
    if (IN(4)) {
        if (bx < SCAN_WGS) { if (!(_rep && SCAN_PROBE_VARIANT == 3)) {
            const int q8 = bx >> 3, h = (bx & 7) * 2 + (q8 & 1), split = q8 >> 1, fg = lane >> 4, fc = lane & 15;
            const bool cwave = wave < SC_NT; const int cw = split * SC_NT + (cwave ? wave : 0);
            const unsigned char* ab = ABLK + (size_t)h * NCH * ABLK_BYTES; const float* Uh = U + (size_t)h * NCH * 8192; const int sv = _rep ? SCAN_PROBE_VARIANT : 0; float* Oh = (_rep ? out : OS) + h * HD + 16 * cw + fc;
            f32x4 S[8]; bf16x8 Sb[4];
#pragma unroll
            for (int kt = 0; kt < 8; ++kt) S[kt] = (f32x4){0.f, 0.f, 0.f, 0.f};
#pragma unroll
            for (int s = 0; s < 4; ++s) Sb[s] = (bf16x8){0, 0, 0, 0, 0, 0, 0, 0};
#define SC_DMA(N_, B_) do { _Pragma("unroll") for (int _i = 0; _i < 7; ++_i) \
        __builtin_amdgcn_global_load_lds((const unsigned*)(ab + (size_t)(N_) * ABLK_BYTES + (wave + 8 * _i) * 1024 + lane * 16), (LAS unsigned*)(L + (B_) * ABLK_BYTES + (wave + 8 * _i) * 1024), 16, 0, 0); } while (0)
#define SC_FRAG(BUF, F_) (*(const LAS bf16x8*)((BUF) + (F_) * 1024 + lane * 16))
#define SC_LD1(F, S_) do { _Pragma("unroll") for (int mt = 0; mt < 4; ++mt) { F[mt] = SC_FRAG(buf, mt * 4 + (S_)); F[4 + mt] = SC_FRAG(buf, 16 + mt * 4 + (S_)); } } while (0)
#define SC_MM1(F, S_) do { _Pragma("unroll") for (int mt = 0; mt < 4; ++mt) { vn[mt] = __builtin_amdgcn_mfma_f32_16x16x32_bf16(F[mt], Sb[S_], vn[mt], 0, 0, 0); \
                                                                             oo[mt] = __builtin_amdgcn_mfma_f32_16x16x32_bf16(F[4 + mt], Sb[S_], oo[mt], 0, 0, 0); } } while (0)
#define SC_SB() __builtin_amdgcn_sched_barrier(0)
            f32x4 ucur[4], unxt[4], oprev[4]; float gcur, gnxt;
#pragma unroll
            for (int mt = 0; mt < 4; ++mt) { ucur[mt] = *(const GAS f32x4*)(Uh + ((mt * 8 + cw) * 64 + lane) * 4); unxt[mt] = ucur[mt]; oprev[mt] = ucur[mt]; }
            gcur = GC[(size_t)h * SEQ + 63]; gnxt = gcur;
            SC_DMA(0, 0);
            VM_WAIT(); __syncthreads();
#pragma unroll 1
            for (int n = 0; n < NCH; ++n) {
                if (n + 1 < NCH) {
                    if (cwave) {
#pragma unroll
                        for (int mt = 0; mt < 4; ++mt) unxt[mt] = *(const GAS f32x4*)(Uh + (size_t)(n + 1) * 8192 + ((mt * 8 + cw) * 64 + lane) * 4);
                        gnxt = GC[(size_t)h * SEQ + 64 * (n + 1) + 63]; }
                    if (sv != 1) SC_DMA(n + 1, (n + 1) & 1); }
                if (cwave && sv != 2) {
                    const float egl = __expf(gcur);
                    const LAS unsigned char* buf = L + (n & 1) * ABLK_BYTES;
                    if (n > 0) {
#pragma unroll
                        for (int mt = 0; mt < 4; ++mt)
#pragma unroll
                            for (int r = 0; r < 4; ++r) Oh[(size_t)(64 * (n - 1) + 16 * mt + 4 * fg + r) * DNW] = oprev[mt][r]; }
                    f32x4 vn[4], oo[4];
#pragma unroll
                    for (int mt = 0; mt < 4; ++mt) { vn[mt] = ucur[mt]; oo[mt] = (f32x4){0.f, 0.f, 0.f, 0.f}; }
                    bf16x8 fa[8], fb[8];
                    SC_LD1(fa, 0); SC_SB();
                    SC_LD1(fb, 1); SC_SB(); SC_MM1(fa, 0); SC_SB();
                    SC_LD1(fa, 2); SC_SB(); SC_MM1(fb, 1); SC_SB();
                    SC_LD1(fb, 3); SC_SB(); SC_MM1(fa, 2); SC_SB();
#pragma unroll
                    for (int q = 0; q < 8; ++q) fa[q] = SC_FRAG(buf, 48 + q);
                    SC_SB(); SC_MM1(fb, 3); SC_SB();
#pragma unroll
                    for (int kt = 0; kt < 8; ++kt) S[kt] = S[kt] * egl;
                    bf16x8 vb2[2];
#pragma unroll
                    for (int s2 = 0; s2 < 2; ++s2) { const v4u w = pg8::pack8(vn[2 * s2], vn[2 * s2 + 1]); vb2[s2] = __builtin_bit_cast(bf16x8, w); }
                    SC_SB();
#pragma unroll
                    for (int q = 0; q < 8; ++q) fb[q] = SC_FRAG(buf, 32 + q);
                    SC_SB();
#pragma unroll
                    for (int s2 = 0; s2 < 2; ++s2)
#pragma unroll
                        for (int kt = 0; kt < 4; ++kt) S[kt] = __builtin_amdgcn_mfma_f32_16x16x32_bf16(fb[kt * 2 + s2], vb2[s2], S[kt], 0, 0, 0);
                    SC_SB();
#pragma unroll
                    for (int q = 0; q < 8; ++q) fb[q] = SC_FRAG(buf, 40 + q);
                    SC_SB();
#pragma unroll
                    for (int s2 = 0; s2 < 2; ++s2)
#pragma unroll
                        for (int mt = 0; mt < 4; ++mt) oo[mt] = __builtin_amdgcn_mfma_f32_16x16x32_bf16(fa[mt * 2 + s2], vb2[s2], oo[mt], 0, 0, 0);
                    SC_SB();
#pragma unroll
                    for (int s2 = 0; s2 < 2; ++s2)
#pragma unroll
                        for (int kt = 0; kt < 4; ++kt) S[4 + kt] = __builtin_amdgcn_mfma_f32_16x16x32_bf16(fb[kt * 2 + s2], vb2[s2], S[4 + kt], 0, 0, 0);
                    SC_SB();
#pragma unroll
                    for (int s = 0; s < 4; ++s) { const v4u w = pg8::pack8(S[2 * s], S[2 * s + 1]); Sb[s] = __builtin_bit_cast(bf16x8, w); }
#pragma unroll
                    for (int mt = 0; mt < 4; ++mt) { oprev[mt] = oo[mt]; ucur[mt] = unxt[mt]; }
                    gcur = gnxt;
                }
                VM_WAIT();
                asm volatile("s_waitcnt lgkmcnt(0)" ::: "memory"); __builtin_amdgcn_s_barrier(); asm volatile("" ::: "memory");
            }
            VM_WAIT();
            if (cwave) {
#pragma unroll
                for (int mt = 0; mt < 4; ++mt)
#pragma unroll
                    for (int r = 0; r < 4; ++r) Oh[(size_t)(64 * (NCH - 1) + 16 * mt + 4 * fg + r) * DNW] = oprev[mt][r]; }
            if (_rep == 0) { CONV_ITEMS_C(0, CV_IN, bx * NWAVES + wave, SCAN_WGS * NWAVES, 3); CONV_ITEMS(CV_TAIL, CV_P3, bx * NWAVES + wave, SCAN_WGS * NWAVES); }
        } } else if (_rep == 0) {
            pg8::Gemm g{HB, WIN_T + (size_t)NPA * LDP(DM), SEQ, NPB1, DM, LDP(DM)}; pg8::StaticOrder S; S.init(SEQ, NPB1, G - SCAN_WGS, bx - SCAN_WGS);
            pg8::EpiProj E{PROJ + NPA, PROJ_LD, BA, -1, AQ, NPA / 256};
            pg8::gemm_phase<pg8::EpiProj, pg8::StaticOrder, GEMM_ALIGN, GEMM_SP2>(L + RING_OFF, g, S, E);
        }
    }
    }
    SEAM(4);

    _Pragma("unroll") for (int _rep = 0; _rep < 1 + REPN * (int)((REPMASK >> 5) & 1u); ++_rep) { if (_rep) xcd_barrier(bar); tid = otid(); lane = tid & 63;
    if (IN(5)) {
        pg8::Gemm g{HB, WIN_T + (size_t)(NPA + NPB1) * LDP(DM), SEQ, NPB2, DM, LDP(DM)}; pg8::StaticOrder S; S.init(SEQ, NPB2, G, (int)blockIdx.x);
        pg8::EpiProj E{PROJ + NPA + NPB1, PROJ_LD, BA, -1, AQ, (NPA + NPB1) / 256};
        pg8::gemm_phase<pg8::EpiProj, pg8::StaticOrder, GEMM_ALIGN, GEMM_SP2>(L + RING_OFF, g, S, E);
        { constexpr int NU = (SEQ / 256) * (NPB2 / 256); const int nfull = NU % G;
          if (nfull && bx >= nfull) CONV_ITEMS(CV_IN, CV_TAIL, (bx - nfull) * NWAVES + wave, (G - nfull) * NWAVES);
          else if (!nfull && bx == 0) CONV_ITEMS(CV_IN, CV_TAIL, wave, NWAVES); }
    }
    }
    SEAM(5);

    _Pragma("unroll") for (int _rep = 0; _rep < 1 + REPN * (int)((REPMASK >> 6) & 1u); ++_rep) { if (_rep) xcd_barrier(bar); tid = otid(); lane = tid & 63;
    if (IN(6)) {
        {
            const int nwg = G; int Lc = bx;
            if (Lc < ATT_ITEMS) {
                typedef swa::BlockRef<swa::bf16, swa::bf16> BR;
                BR cur; int dcur; att_ref(cur, dcur, Lc, AQ, OG, LSEB);
                swa::Seam<swa::bf16> Sm;
                swa::causal_swa_prime<swa::bf16, swa::bf16>(cur, 129, (char*)lds, Sm);
                for (;;) {
                    const int Ln = Lc + nwg; const bool last = Ln >= ATT_ITEMS;
                    BR nxt = cur; int dn = dcur; if (!last) att_ref(nxt, dn, Ln, AQ, OG, LSEB);
                    swa::causal_swa_block<swa::bf16, swa::bf16>(cur, nxt, SEQ / dcur, 129, (char*)lds, Sm);
                    if (last) break;
                    cur = nxt; dcur = dn; Lc = Ln;
                }
            }
        }
    }
    }
    SEAM(6);


    _Pragma("unroll") for (int _rep = 0; _rep < 1 + REPN * (int)((REPMASK >> 7) & 1u); ++_rep) { if (_rep) xcd_barrier(bar); tid = otid(); lane = tid & 63;
    if (IN(7)) {
        for (int t = gw; t < SEQ; t += NGW) {
            {
#pragma unroll
              for (int j = 0; j < 4; ++j) { const int col = 256 * j + 4 * lane, hh = col >> 7;
                  const float l0 = LSEB[(size_t)t * 8 + hh], l1 = LSEB[(size_t)SEQ * 8 + (size_t)t * 8 + hh], l2 = LSEB[(size_t)2 * SEQ * 8 + (size_t)t * 8 + hh];
                  const float mx = fmaxf(l0, fmaxf(l1, l2)); const float e0 = __expf(l0 - mx), e1 = __expf(l1 - mx), e2 = __expf(l2 - mx); const float inv = 1.0f / (e0 + e1 + e2);
                  const unsigned long long w0 = *(const GAS unsigned long long*)(OG + (size_t)t * ATW + col), w1 = *(const GAS unsigned long long*)(OG + (size_t)SEQ * ATW + (size_t)t * ATW + col), w2 = *(const GAS unsigned long long*)(OG + (size_t)2 * SEQ * ATW + (size_t)t * ATW + col);
#define UNP4(w_) (f32x4){__uint_as_float((unsigned)(w_) << 16), __uint_as_float((unsigned)(w_) & 0xffff0000u), __uint_as_float((unsigned)((w_) >> 32) << 16), __uint_as_float((unsigned)((w_) >> 32) & 0xffff0000u)}
                  const f32x4 a0 = UNP4(w0), a1 = UNP4(w1), a2 = UNP4(w2);
#undef UNP4
                  const f32x4 y = (a0 * e0 + a1 * e1 + a2 * e2) * inv;
                  *(GAS unsigned long long*)(OA + kt_off((size_t)t, DNW + col, ATW + DNW)) = (unsigned long long)pk2(y.x, y.y) | ((unsigned long long)pk2(y.z, y.w) << 32); } }
            const GAS f32x4* op = (const GAS f32x4*)(OS + (size_t)t * DNW) + lane;
#pragma unroll
            for (int j = 0; j < 8; ++j) { const f32x4 v = op[64 * j]; float ss = (v.x * v.x + v.y * v.y) + (v.z * v.z + v.w * v.w);
                ss += __shfl_xor(ss, 1); ss += __shfl_xor(ss, 2); ss += __shfl_xor(ss, 4); ss += __shfl_xor(ss, 8); ss += __shfl_xor(ss, 16);
                const float rstd = 1.0f / sqrtf(ss * (1.f / HD) + EPS); const int col = 256 * j + 4 * lane; const f32x4 gn = *(const GAS f32x4*)(dn_norm + (col & 127));
                const unsigned long long zw = *(const GAS unsigned long long*)(PROJ + (size_t)t * PROJ_LD + C_ZB + col);
                const f32x4 z = {__uint_as_float((unsigned)zw << 16), __uint_as_float((unsigned)zw & 0xffff0000u), __uint_as_float((unsigned)(zw >> 32) << 16), __uint_as_float((unsigned)(zw >> 32) & 0xffff0000u)};
                const f32x4 y = v * rstd * gn * (z * pg8::sigm4(z));
                *(GAS unsigned long long*)(OA + kt_off((size_t)t, col, ATW + DNW)) = (unsigned long long)pk2(y.x, y.y) | ((unsigned long long)pk2(y.z, y.w) << 32); }
        }
    }
    }
    SEAM(7);

    _Pragma("unroll") for (int _rep = 0; _rep < 1 + REPN * (int)((REPMASK >> 9) & 1u); ++_rep) { if (_rep) xcd_barrier(bar); tid = otid(); lane = tid & 63;
    if (IN(9)) {
        pg8::Gemm g{OA, WAU_T, SEQ, DM, ATW + DNW, LDP(ATW + DNW)}; pg8::SegOrder S; S.init(SEQ, DM, G, (int)blockIdx.x);
        pg8::EpiMerge E{PROJ + C_GA, PROJ + C_GB, PROJ_LD, MERGED, LDP(DM)};
        pg8::gemm_phase<pg8::EpiMerge, pg8::SegOrder, GEMM_ALIGN, GEMM_SP2>(L + RING_OFF, g, S, E);
    }
    }
    SEAM(9);
    _Pragma("unroll") for (int _rep = 0; _rep < 1 + REPN * (int)((REPMASK >> 10) & 1u); ++_rep) { if (_rep) xcd_barrier(bar); tid = otid(); lane = tid & 63;
    if (IN(10)) {
        { pg8::Gemm g{MERGED, WOUT_T, SEQ, DM, DM, LDP(DM)}; pg8::StaticOrder S; S.init(SEQ, DM, G, (int)blockIdx.x);
          pg8::EpiResidN<true> E{x, X1, DM, SSQ1, nullptr};
          pg8::gemm_phase<pg8::EpiResidN<true>, pg8::StaticOrder, GEMM_ALIGN, GEMM_SP2>(L + RING_OFF, g, S, E); }
        { pg8::Gemm g{PB, WPP_T, SEQ, DM, PLE, LDP(PLE)}; pg8::StaticOrder S; S.init(SEQ, DM, G, (int)blockIdx.x);
          pg8::EpiF32N E{PP, DM, SSQP};
          pg8::gemm_phase<pg8::EpiF32N, pg8::StaticOrder, GEMM_ALIGN, GEMM_SP2>(L + RING_OFF, g, S, E); }
    }
    }
    SEAM(10);
    _Pragma("unroll") for (int _rep = 0; _rep < 1 + REPN * (int)((REPMASK >> 11) & 1u); ++_rep) { if (_rep) xcd_barrier(bar); tid = otid(); lane = tid & 63;
    if (IN(11)) { }
    }
    _Pragma("unroll") for (int _rep = 0; _rep < 1 + REPN * (int)((REPMASK >> 12) & 1u); ++_rep) { if (_rep) xcd_barrier(bar); tid = otid(); lane = tid & 63;
    if (IN(12)) {
        pg8::Gemm g{X1, WUP_T, SEQ, DFF, DM, LDP(DM)}; pg8::StaticOrder S; S.init(SEQ, DFF, G, (int)blockIdx.x);
        pg8::EpiRelu2S E{HID, LDP(DFF)};
        pg8::gemm_phase<pg8::EpiRelu2S, pg8::StaticOrder, GEMM_ALIGN, GEMM_SP2>(L + RING_OFF, g, S, E);
    }
    }
    SEAM(12);
    _Pragma("unroll") for (int _rep = 0; _rep < 1 + REPN * (int)((REPMASK >> 13) & 1u); ++_rep) { if (_rep) xcd_barrier(bar); tid = otid(); lane = tid & 63;
    if (IN(13)) {
        pg8::Gemm g{HID, WDN_T, SEQ, DM, DFF, LDP(DFF)}; pg8::StaticOrder S; S.init(SEQ, DM, G, (int)blockIdx.x);
        { const int pm0 = static_pm0(SEQ, DM, (int)blockIdx.x); panel_rstd(SSQ1, RSTD1, pm0, tid); __syncthreads(); }
        pg8::EpiResidN<false, true> E{X1, X2, DM, SSQ2, RSTD1};
        pg8::gemm_phase<pg8::EpiResidN<false, true>, pg8::StaticOrder, GEMM_ALIGN, GEMM_SP2>(L + RING_OFF, g, S, E);
    }
    }
    SEAM(13);
#ifdef PROBE_CACHED_GEMM
    {
        struct CachedOrder : pg8::StaticOrder { __device__ bool next(int i, pg8::Unit& u) const { const bool r = pg8::StaticOrder::next(i, u); u.pm &= 1; u.pn &= 1; return r; } };
        xcd_barrier(bar);
        pg8::Gemm g{HID, WDN_T, SEQ, DM, DFF, LDP(DFF)}; CachedOrder S; S.init(SEQ, DM, G, (int)blockIdx.x);
        pg8::EpiF32 E{T1, DM};
        pg8::gemm_phase<pg8::EpiF32, CachedOrder, GEMM_ALIGN, GEMM_SP2>(L + RING_OFF, g, S, E);
        xcd_barrier(bar);
    }
#endif
    _Pragma("unroll") for (int _rep = 0; _rep < 1 + REPN * (int)((REPMASK >> 14) & 1u); ++_rep) { if (_rep) xcd_barrier(bar); tid = otid(); lane = tid & 63;
    if (IN(14)) { }
    }
#ifdef PROBE_BARRIERS
    for (int _b = 0; _b < PROBE_BARRIERS; ++_b) xcd_barrier(bar);
#endif
    _Pragma("unroll") for (int _rep = 0; _rep < 1 + REPN * (int)((REPMASK >> 15) & 1u); ++_rep) { if (_rep) xcd_barrier(bar); tid = otid(); lane = tid & 63;
    if (IN(15)) {
        pg8::Gemm g{X2, WG_T, SEQ, DM, DM, LDP(DM)}; pg8::StaticOrder S; S.init(SEQ, DM, G, (int)blockIdx.x);
        { const int pm0 = static_pm0(SEQ, DM, (int)blockIdx.x); panel_rstd(SSQ2, RSTD2, pm0, tid); panel_rstd(SSQP, RSTDP, pm0, tid); __syncthreads(); }
        pg8::EpiPleN E{X2, PP, X1, DM, RSTD2, RSTDP, ple_post_norm};
        pg8::gemm_phase<pg8::EpiPleN, pg8::StaticOrder, GEMM_ALIGN, GEMM_SP2>(L + RING_OFF, g, S, E);
    }
    }
    SEAM(15);
    _Pragma("unroll") for (int _rep = 0; _rep < 1 + REPN * (int)((REPMASK >> 16) & 1u); ++_rep) { if (_rep) xcd_barrier(bar); tid = otid(); lane = tid & 63;
    if (IN(16)) { for (int m = gw; m < SEQ; m += NGW) norm_row_b2f(X1 + (size_t)m * DM, final_norm, out + (size_t)m * DM, lane); }
    }
#undef IN
#undef SEAM
}

#ifndef MK_N_LAUNCHES
#define MK_N_LAUNCHES 1
#endif
extern "C" void kernel_launch(void* const* d_in, const int* in_sizes, int n_in, void* d_out, int out_size, void* d_ws, size_t ws_size, hipStream_t stream) {
    static int grid = 0;
    if (grid == 0) {
        if (n_in != 19 || in_sizes[0] != SEQ * DM || out_size != SEQ * DM || ws_size < WS_END) { fprintf(stderr, "kernel_launch: unexpected shapes: n_in %d in0 %d out %d ws %zu (need %zu)\n", n_in, n_in > 0 ? in_sizes[0] : -1, out_size, ws_size, (size_t)WS_END); grid = -1; return; }
        int dev = 0, cus = 0, per_cu = 0;
        if (hipGetDevice(&dev) != hipSuccess || hipDeviceGetAttribute(&cus, hipDeviceAttributeMultiprocessorCount, dev) != hipSuccess) { grid = -1; return; }
        if (hipFuncSetAttribute((const void*)mk_fwd, hipFuncAttributeMaxDynamicSharedMemorySize, LDS_BYTES) != hipSuccess) { fprintf(stderr, "kernel_launch: hipFuncSetAttribute failed\n"); grid = -1; return; }
        if (hipOccupancyMaxActiveBlocksPerMultiprocessor(&per_cu, (const void*)mk_fwd, NWAVES * 64, LDS_BYTES) != hipSuccess || per_cu < 1) fprintf(stderr, "kernel_launch: occupancy query says %d\n", per_cu);
        (void)hipGetLastError();
        grid = cus;
    }
    if (grid < 0) return;
    if (hipMemsetAsync((char*)d_ws + WS_CTL, 0, CTL_ZERO_BYTES, stream) != hipSuccess) return;
    Args a{};
    for (int i = 0; i < 19; ++i) a.in[i] = (const float*)d_in[i];
    a.out = (float*)d_out; a.ws = (unsigned char*)d_ws;
    for (int li = 0; li < MK_N_LAUNCHES; ++li) {
        a.ph_lo = li * N_PHASES / MK_N_LAUNCHES; a.ph_hi = (li + 1) * N_PHASES / MK_N_LAUNCHES; a.li = li;
        hipLaunchKernelGGL(mk_fwd, dim3(grid), dim3(NWAVES * 64), LDS_BYTES, stream, a);
        const hipError_t le = hipPeekAtLastError();
        if (le != hipSuccess) { fprintf(stderr, "kernel_launch: launch %d failed: %s\n", li, hipGetErrorName(le)); break; }
    }
}
```
